# Optimizing an MI355X kernel written in HIP

```python
import math
import jax, jax.numpy as jnp
from jax import lax
import numpy as np

D_MODEL = 2048
BATCH = 4
SEQ = 4096
DEPTH = 4

N_DIFF_HEADS = 8
DIFF_HEAD_DIM = 64
DIFF_V_DIM = 2 * DIFF_HEAD_DIM
ATTN_WIDTH = N_DIFF_HEADS * DIFF_V_DIM
CONV_WIDTH = D_MODEL - ATTN_WIDTH
CONV_K = 3
IN_PROJ_WIDTH = 3 * ATTN_WIDTH + 3 * CONV_WIDTH
D_FF = -(-8 * D_MODEL // (3 * 256)) * 256
ROPE_THETA = 10000.0
EPS = 1e-6
Q_BLOCK = 128

kernel_name = 'hybrid_diffattn_shortconv_encoder'


def rmsnorm(t, g):
    tf = t.astype(jnp.float32)
    tf = tf * lax.rsqrt(jnp.mean(tf * tf, axis=-1, keepdims=True) + EPS)
    return (tf * g.astype(jnp.float32)).astype(t.dtype)


def rope_tables(seq):
    pos = jnp.arange(seq, dtype=jnp.float32)
    inv_freq = ROPE_THETA ** (-jnp.arange(0, DIFF_HEAD_DIM, 2, dtype=jnp.float32) / DIFF_HEAD_DIM)
    ang = pos[:, None] * inv_freq[None, :]
    return jnp.cos(ang)[:, None, :], jnp.sin(ang)[:, None, :]


def apply_rope(t, cos, sin):
    tf = t.astype(jnp.float32)
    t1, t2 = jnp.split(tf, 2, axis=-1)
    return jnp.concatenate([t1 * cos - t2 * sin, t2 * cos + t1 * sin], axis=-1).astype(t.dtype)


def diff_attention(q, k, v, lam):
    b, s = q.shape[0], q.shape[1]
    nb = s // Q_BLOCK
    scale = DIFF_HEAD_DIM ** -0.5
    qf = (q.astype(jnp.float32) * scale).reshape(b, nb, Q_BLOCK, 2 * N_DIFF_HEADS, DIFF_HEAD_DIM)
    qf = qf.transpose(1, 0, 2, 3, 4)
    kf = k.astype(jnp.float32)

    def one_block(qb):
        sc = jnp.einsum('bqhd,bkhd->bhqk', qb, kf)
        p = jax.nn.softmax(sc, axis=-1).reshape(b, N_DIFF_HEADS, 2, Q_BLOCK, s)
        w = p[:, :, 0] - lam * p[:, :, 1]
        return jnp.einsum('bhqk,bkhe->bqhe', w.astype(v.dtype), v)

    o = lax.map(one_block, qf)
    return o.transpose(1, 0, 2, 3, 4).reshape(b, s, N_DIFF_HEADS, DIFF_V_DIM)


def short_gated_conv(gate_b, gate_c, u, w):
    z = gate_c * u
    zp = jnp.pad(z, ((0, 0), (1, 1), (0, 0)))
    y = zp[:, :-2] * w[0] + zp[:, 1:-1] * w[1] + zp[:, 2:] * w[2]
    return gate_b * y


def setup_inputs(seed: int = 0) -> dict:
    key = jax.random.key(seed)
    ks = jax.random.split(key, 15)
    f32 = jnp.float32
    nrm = lambda k, shape, s: jax.random.normal(k, shape, f32) * s
    return {
        'x': nrm(ks[0], (BATCH, SEQ, D_MODEL), 1.0),
        'norm_mix': 1.0 + nrm(ks[1], (DEPTH, D_MODEL), 0.02),
        'w_in': nrm(ks[2], (DEPTH, D_MODEL, IN_PROJ_WIDTH), D_MODEL ** -0.5),
        'lambda_q1': nrm(ks[3], (DEPTH, DIFF_HEAD_DIM), 0.1),
        'lambda_k1': nrm(ks[4], (DEPTH, DIFF_HEAD_DIM), 0.1),
        'lambda_q2': nrm(ks[5], (DEPTH, DIFF_HEAD_DIM), 0.1),
        'lambda_k2': nrm(ks[6], (DEPTH, DIFF_HEAD_DIM), 0.1),
        'subln': 1.0 + nrm(ks[7], (DEPTH, DIFF_V_DIM), 0.02),
        'conv_w': nrm(ks[8], (DEPTH, CONV_K, CONV_WIDTH), CONV_K ** -0.5),
        'w_out': nrm(ks[9], (DEPTH, D_MODEL, D_MODEL), D_MODEL ** -0.5),
        'norm_ffn': 1.0 + nrm(ks[10], (DEPTH, D_MODEL), 0.02),
        'w_gate': nrm(ks[11], (DEPTH, D_MODEL, D_FF), D_MODEL ** -0.5),
        'w_up': nrm(ks[12], (DEPTH, D_MODEL, D_FF), D_MODEL ** -0.5),
        'w_down': nrm(ks[13], (DEPTH, D_FF, D_MODEL), D_FF ** -0.5),
        'norm_final': 1.0 + nrm(ks[14], (D_MODEL,), 0.02),
    }


def reference(x, norm_mix, w_in, lambda_q1, lambda_k1, lambda_q2, lambda_k2, subln,
              conv_w, w_out, norm_ffn, w_gate, w_up, w_down, norm_final):
    b, s, _ = x.shape
    cos, sin = rope_tables(s)
    splits = [ATTN_WIDTH, 2 * ATTN_WIDTH, 3 * ATTN_WIDTH,
              3 * ATTN_WIDTH + CONV_WIDTH, 3 * ATTN_WIDTH + 2 * CONV_WIDTH]
    for l in range(DEPTH):
        lam_init = 0.8 - 0.6 * math.exp(-0.3 * l)
        h = rmsnorm(x, norm_mix[l])
        proj = h @ w_in[l]
        q, k, v, gate_b, gate_c, u = jnp.split(proj, splits, axis=-1)
        q = apply_rope(q.reshape(b, s, 2 * N_DIFF_HEADS, DIFF_HEAD_DIM), cos, sin)
        k = apply_rope(k.reshape(b, s, 2 * N_DIFF_HEADS, DIFF_HEAD_DIM), cos, sin)
        v = v.reshape(b, s, N_DIFF_HEADS, DIFF_V_DIM)
        lam = (jnp.exp(jnp.sum(lambda_q1[l].astype(jnp.float32) * lambda_k1[l].astype(jnp.float32)))
               - jnp.exp(jnp.sum(lambda_q2[l].astype(jnp.float32) * lambda_k2[l].astype(jnp.float32)))
               + lam_init)
        o_attn = diff_attention(q, k, v, lam)
        o_attn = (rmsnorm(o_attn, subln[l]) * (1.0 - lam_init)).reshape(b, s, ATTN_WIDTH)
        o_conv = short_gated_conv(gate_b, gate_c, u, conv_w[l])
        x = x + jnp.concatenate([o_attn.astype(x.dtype), o_conv.astype(x.dtype)], axis=-1) @ w_out[l]
        h = rmsnorm(x, norm_ffn[l])
        x = x + (jax.nn.silu(h @ w_gate[l]) * (h @ w_up[l])) @ w_down[l]
    return rmsnorm(x, norm_final)
```

```cpp
#include <hip/hip_runtime.h>
#include <hip/hip_cooperative_groups.h>
#include <hip/hip_bf16.h>
#include <cstdio>
#include <cstdint>
#include <cmath>
namespace cg = cooperative_groups;
namespace pg8 {
#define PG8_LAS __attribute__((address_space(3)))
typedef unsigned short bf16_t;
typedef short bf16x8 __attribute__((ext_vector_type(8)));
typedef float f32x4 __attribute__((ext_vector_type(4)));
typedef unsigned u32x4 __attribute__((ext_vector_type(4)));
constexpr int BM = 256, BK = 64, HALF = 128, HTB = HALF * BK * 2  , STAGE_BYTES = 8 * HTB, NXCD = 8, WGM = 8;

__host__ __device__ __forceinline__ int lds_byte(int r, int c) { const int st = (r >> 4) * 2 + (c >> 5), rr = r & 15, cc = c & 31, ob = rr * 64 + cc * 2; return st * 1024 + (ob ^ (((ob >> 9) & 1) << 5)); }
__host__ __device__ __forceinline__ void stage_rc(int b, int& R, int& C) { const int st = b / 1024, sb = b % 1024, swz = sb ^ (((sb >> 9) & 1) << 5); R = (st >> 1) * 16 + swz / 64; C = (st & 1) * 32 + (swz % 64) / 2; }
__host__ __device__ __forceinline__ int perm32(int rho) { const int n = rho >> 4, i = rho & 15; return 8 * (i >> 2) + 4 * n + (i & 3); }

struct Unit { int pm, pn; };
struct Gemm { const bf16_t* A; const bf16_t* Bt; int M, N, K; };

struct StaticOrder {
    int nM, nN, nwg, G, c;
    __host__ __device__ void init(int M, int N, int G_, int c_) { nM = M / BM; nN = N / BM; nwg = nM * nN; G = G_; c = c_; }
    __host__ __device__ bool next(int i, Unit& u) const {
        const long L = (long)i * G + c; if (L >= nwg) return false;
        int wgid = (int)L; { const int q = nwg / NXCD, r = nwg % NXCD, xcd = wgid % NXCD, off = wgid / NXCD; wgid = (xcd < r ? xcd * (q + 1) : r * (q + 1) + (xcd - r) * q) + off; }
        const int nig = WGM * nN, gid = wgid / nig, fm = gid * WGM, gsz = (nM - fm) < WGM ? (nM - fm) : WGM;
        u.pm = fm + ((wgid % nig) % gsz); u.pn = (wgid % nig) / gsz; return true;
    }
    __device__ __forceinline__ void a_ready(const Unit&) const {}
    __device__ __forceinline__ void done(const Unit&) const {}
};

__device__ __forceinline__ unsigned cvt_pk_bf16(float lo, float hi) { unsigned r; asm volatile("v_cvt_pk_bf16_f32 %0, %1, %2" : "=v"(r) : "v"(lo), "v"(hi)); return r; }
typedef float f32x2 __attribute__((ext_vector_type(2)));
typedef unsigned u32x2 __attribute__((ext_vector_type(2)));
constexpr float QSCALE = 0.125f * 1.4426950408889634f;

struct EpiInProj {
    static constexpr bool PERM = true, AFTER_DRAIN = false;
    bf16_t* O; int ldc; const float* cosT; const float* sinT; const float* ssq; float inv_d, eps;
    __device__ __forceinline__ void operator()(const f32x4 (&acc)[2][2][4][2], const Unit& u, int wr, int wc, int fr, int fq) const {
        const int row0 = u.pm * BM + wr * 64 + fr;
        if (u.pn < 8) {
            const float sc = (u.pn < 4) ? QSCALE : 1.f;
            const int col = u.pn * BM + 64 * wc + 8 * fq;
#pragma unroll
            for (int ai = 0; ai < 2; ++ai)
#pragma unroll
                for (int m = 0; m < 4; ++m) { const int row = row0 + ai * HALF + m * 16; const int pos = row & 4095;
                    const float rs = ssq ? sc * __builtin_amdgcn_rsqf(ssq[row] * inv_d + eps) : sc;
                    const f32x4 c0 = *(const f32x4*)(cosT + pos * 32 + 8 * fq), c1 = *(const f32x4*)(cosT + pos * 32 + 8 * fq + 4);
                    const f32x4 s0 = *(const f32x4*)(sinT + pos * 32 + 8 * fq), s1 = *(const f32x4*)(sinT + pos * 32 + 8 * fq + 4);
                    const f32x4 a0 = acc[ai][0][m][0], a1 = acc[ai][0][m][1], b0 = acc[ai][1][m][0], b1 = acc[ai][1][m][1];
                    const f32x4 x0 = (a0 * c0 - b0 * s0) * rs, x1 = (a1 * c1 - b1 * s1) * rs, y0 = (b0 * c0 + a0 * s0) * rs, y1 = (b1 * c1 + a1 * s1) * rs;
                    bf16_t* rowp = O + (size_t)row * ldc + col;
                    u32x4 w; w.x = cvt_pk_bf16(x0[0], x0[1]); w.y = cvt_pk_bf16(x0[2], x0[3]); w.z = cvt_pk_bf16(x1[0], x1[1]); w.w = cvt_pk_bf16(x1[2], x1[3]);
                    *(u32x4*)rowp = w;
                    w.x = cvt_pk_bf16(y0[0], y0[1]); w.y = cvt_pk_bf16(y0[2], y0[3]); w.z = cvt_pk_bf16(y1[0], y1[1]); w.w = cvt_pk_bf16(y1[2], y1[3]);
                    *(u32x4*)(rowp + 32) = w; }
        } else {
            const int col0 = u.pn * BM + wc * 32 + 8 * fq;
#pragma unroll
            for (int ai = 0; ai < 2; ++ai)
#pragma unroll
                for (int m = 0; m < 4; ++m) { const int row = row0 + ai * HALF + m * 16; bf16_t* rowp = O + (size_t)row * ldc + col0;
                    const float rs = ssq ? __builtin_amdgcn_rsqf(ssq[row] * inv_d + eps) : 1.f;
#pragma unroll
                    for (int bj = 0; bj < 2; ++bj) { const f32x4 v0 = acc[ai][bj][m][0] * rs, v1 = acc[ai][bj][m][1] * rs;
                        u32x4 w; w.x = cvt_pk_bf16(v0[0], v0[1]); w.y = cvt_pk_bf16(v0[2], v0[3]); w.z = cvt_pk_bf16(v1[0], v1[1]); w.w = cvt_pk_bf16(v1[2], v1[3]);
                        *(u32x4*)(rowp + bj * HALF) = w; } }
        }
    }
};
struct EpiResid {
    static constexpr bool PERM = true, AFTER_DRAIN = false;
    const float* base; float* out; int ldc; bf16_t* xb; float* ssq;
    __device__ __forceinline__ void operator()(const f32x4 (&acc)[2][2][4][2], const Unit& u, int wr, int wc, int fr, int fq) const {
        const int row0 = u.pm * BM + wr * 64 + fr, col0 = u.pn * BM + wc * 32 + 8 * fq;
#pragma unroll
        for (int ai = 0; ai < 2; ++ai)
#pragma unroll
            for (int m = 0; m < 4; ++m) { const int row = row0 + ai * HALF + m * 16; const size_t off = (size_t)row * ldc + col0; float s = 0.f;
#pragma unroll
                for (int bj = 0; bj < 2; ++bj) {
                    const f32x4 v0 = *(const f32x4*)(base + off + bj * HALF) + acc[ai][bj][m][0], v1 = *(const f32x4*)(base + off + bj * HALF + 4) + acc[ai][bj][m][1];
                    *(f32x4*)(out + off + bj * HALF) = v0; *(f32x4*)(out + off + bj * HALF + 4) = v1;
                    if (xb) { u32x4 w; w.x = cvt_pk_bf16(v0[0], v0[1]); w.y = cvt_pk_bf16(v0[2], v0[3]); w.z = cvt_pk_bf16(v1[0], v1[1]); w.w = cvt_pk_bf16(v1[2], v1[3]); *(u32x4*)(xb + off + bj * HALF) = w; }
                    s += (v0[0] * v0[0] + v0[1] * v0[1]) + (v0[2] * v0[2] + v0[3] * v0[3]) + (v1[0] * v1[0] + v1[1] * v1[1]) + (v1[2] * v1[2] + v1[3] * v1[3]); }
                if (ssq) { s += __shfl_xor(s, 16); s += __shfl_xor(s, 32); if (fq == 0) atomicAdd(ssq + row, s); } }
    }
};
struct EpiSwiGLU {
    static constexpr bool PERM = true, AFTER_DRAIN = false;
    bf16_t* O; int ldc; const float* ssq; float inv_d, eps;
    __device__ __forceinline__ void operator()(const f32x4 (&acc)[2][2][4][2], const Unit& u, int wr, int wc, int fr, int fq) const {
        const int row0 = u.pm * BM + wr * 64 + fr, col0 = u.pn * HALF + wc * 32 + 8 * fq;
#pragma unroll
        for (int ai = 0; ai < 2; ++ai)
#pragma unroll
            for (int m = 0; m < 4; ++m) { const int row = row0 + ai * HALF + m * 16;
                const float rs = ssq ? __builtin_amdgcn_rsqf(ssq[row] * inv_d + eps) : 1.f;
                float h[8];
#pragma unroll
                for (int n = 0; n < 2; ++n)
#pragma unroll
                    for (int e = 0; e < 4; ++e) { const float g = acc[ai][0][m][n][e] * rs, up = acc[ai][1][m][n][e] * rs;
                        h[n * 4 + e] = g * up * __builtin_amdgcn_rcpf(1.f + __builtin_amdgcn_exp2f(-1.4426950408889634f * g)); }
                u32x4 w; w.x = cvt_pk_bf16(h[0], h[1]); w.y = cvt_pk_bf16(h[2], h[3]); w.z = cvt_pk_bf16(h[4], h[5]); w.w = cvt_pk_bf16(h[6], h[7]);
                *(u32x4*)(O + (size_t)row * ldc + col0) = w; }
    }
};
template <class Epi, class Sched, bool ALIGN_EPI = false, bool SP2 = false>
__device__ __forceinline__ void gemm_phase(PG8_LAS unsigned char* lds, const Gemm g, const Sched& S, const Epi& E) {
    int tid_ = threadIdx.x; asm volatile("" : "+v"(tid_));
    const int tid = tid_, wid = __builtin_amdgcn_readfirstlane(tid >> 6), lane = tid & 63, wr = wid >> 2, wc = wid & 3, fr = lane & 15, fq = lane >> 4;
    const int K = g.K, nt = K / BK;
    unsigned voffA[2], voffB[2];
#pragma unroll
    for (int i = 0; i < 2; ++i) { int R, C; stage_rc(tid * 16 + i * 8192, R, C); const int Rb = Epi::PERM ? ((R & ~31) + perm32(R & 31)) : R;
        voffA[i] = (unsigned)(R * K + C) * 2u; voffB[i] = (unsigned)(Rb * K + C) * 2u; }
    const size_t kstep = (size_t)(BK * 2);
    const size_t hstep = (size_t)HALF * K * 2;
    const size_t tstep = 2 * hstep;
    const unsigned ldsw = (unsigned)wid * 1024u;
    const int aoff = lds_byte(wr * 64 + fr, fq * 8), boff = lds_byte(wc * 32 + fr, fq * 8);
#define PG8_SA(b, h) (((b) * 2 + (h)) * HTB)
#define PG8_SB(b, h) ((4 + (b) * 2 + (h)) * HTB)
#define PG8_STAGE(bufoff, gbase, voff) do { _Pragma("unroll") for (int _i = 0; _i < 2; ++_i) \
        __builtin_amdgcn_global_load_lds((const unsigned*)((const char*)(gbase) + (voff)[_i]), (PG8_LAS unsigned*)(lds + (bufoff) + ldsw + _i * 8192), 16, 0, 0); } while (0)
#define PG8_LDA(dst, b, h) do { _Pragma("unroll") for (int m = 0; m < 4; ++m) _Pragma("unroll") for (int k = 0; k < 2; ++k) dst[m][k] = *(const PG8_LAS bf16x8*)(lds + PG8_SA(b, h) + aoff + m * 2048 + k * 1024); } while (0)
#define PG8_LDB(dst, b, h) do { _Pragma("unroll") for (int n = 0; n < 2; ++n) _Pragma("unroll") for (int k = 0; k < 2; ++k) dst[n][k] = *(const PG8_LAS bf16x8*)(lds + PG8_SB(b, h) + boff + n * 2048 + k * 1024); } while (0)
#define PG8_MMA(ai, bj, At, Bt) do { __builtin_amdgcn_s_setprio(1); _Pragma("unroll") for (int m = 0; m < 4; ++m) _Pragma("unroll") for (int n = 0; n < 2; ++n) _Pragma("unroll") for (int k = 0; k < 2; ++k) \
        acc[ai][bj][m][n] = __builtin_amdgcn_mfma_f32_16x16x32_bf16(Bt[n][k], At[m][k], acc[ai][bj][m][n], 0, 0, 0); __builtin_amdgcn_s_setprio(0); } while (0)
#define PG8_WAIT_V(n) asm volatile("s_waitcnt vmcnt(" #n ")" ::: "memory")
#define PG8_WAIT_L(n) asm volatile("s_waitcnt lgkmcnt(" #n ")" ::: "memory")
#define PG8_BAR __builtin_amdgcn_s_barrier()
#define PG8_SCHED __builtin_amdgcn_sched_barrier(0)
    Unit cur, nxt; int ui = 0;
    if (!S.next(0, cur)) return;
    f32x4 acc[2][2][4][2];
#pragma unroll
    for (int a = 0; a < 2; ++a)
#pragma unroll
        for (int b = 0; b < 2; ++b)
#pragma unroll
            for (int m = 0; m < 4; ++m)
#pragma unroll
                for (int n = 0; n < 2; ++n) acc[a][b][m][n] = (f32x4){0.f, 0.f, 0.f, 0.f};
    bf16x8 At[4][2], B0[2][2], B1[2][2];
    const char* cA = (const char*)g.A + (size_t)cur.pm * tstep; const char* cB = (const char*)g.Bt + (size_t)cur.pn * tstep;
    S.a_ready(cur);
    if constexpr (SP2) {
        PG8_STAGE(PG8_SB(0, 0), cB, voffB); PG8_STAGE(PG8_SB(0, 1), cB + hstep, voffB); PG8_STAGE(PG8_SA(0, 0), cA, voffA); PG8_STAGE(PG8_SA(0, 1), cA + hstep, voffA);
        if (wr == 1) PG8_BAR;
        PG8_WAIT_V(2); PG8_BAR;
        PG8_STAGE(PG8_SB(1, 0), cB + kstep, voffB); PG8_STAGE(PG8_SA(1, 0), cA + kstep, voffA); PG8_STAGE(PG8_SB(1, 1), cB + hstep + kstep, voffB);
        PG8_WAIT_V(6); PG8_BAR;
    } else {
        PG8_STAGE(PG8_SB(0, 0), cB, voffB); PG8_STAGE(PG8_SA(0, 0), cA, voffA); PG8_STAGE(PG8_SB(0, 1), cB + hstep, voffB); PG8_STAGE(PG8_SA(0, 1), cA + hstep, voffA);
        if (wr == 1) PG8_BAR;
        PG8_WAIT_V(4); PG8_BAR;
        PG8_STAGE(PG8_SB(1, 0), cB + kstep, voffB); PG8_STAGE(PG8_SA(1, 0), cA + kstep, voffA); PG8_STAGE(PG8_SB(1, 1), cB + hstep + kstep, voffB);
        PG8_WAIT_V(6); PG8_BAR;
    }
    for (;;) {
        const bool has_next = S.next(ui + 1, nxt);
        const char* nA = has_next ? (const char*)g.A + (size_t)nxt.pm * tstep : cA; const char* nB = has_next ? (const char*)g.Bt + (size_t)nxt.pn * tstep : cB;
        for (int t = 0; t < nt; t += 2) {
            const bool last = (t == nt - 2);
            const char* a1 = cA + (size_t)(t + 1) * kstep;
            const char* a2 = last ? nA : cA + (size_t)(t + 2) * kstep; const char* b2 = last ? nB : cB + (size_t)(t + 2) * kstep;
            const char* a3 = a2 + kstep; const char* b3 = b2 + kstep;
            if (last && has_next) S.a_ready(nxt);
            if constexpr (SP2) {
            PG8_LDB(B0, 0, 0); PG8_LDB(B1, 0, 1); PG8_SCHED; PG8_LDA(At, 0, 0); PG8_STAGE(PG8_SA(1, 1), a1 + hstep, voffA);
            PG8_WAIT_V(8); PG8_WAIT_L(0); PG8_BAR; PG8_MMA(0, 0, At, B0); PG8_MMA(0, 1, At, B1); PG8_BAR; PG8_SCHED;
            PG8_LDA(At, 0, 1); PG8_STAGE(PG8_SB(0, 0), b2, voffB); PG8_STAGE(PG8_SB(0, 1), b2 + hstep, voffB); PG8_STAGE(PG8_SA(0, 0), a2, voffA);
            PG8_WAIT_V(8); PG8_WAIT_L(0); PG8_BAR; PG8_MMA(1, 0, At, B0); PG8_MMA(1, 1, At, B1); PG8_BAR; PG8_SCHED;
            PG8_LDB(B0, 1, 0); PG8_LDB(B1, 1, 1); PG8_SCHED; PG8_LDA(At, 1, 0); PG8_STAGE(PG8_SA(0, 1), a2 + hstep, voffA);
            PG8_WAIT_V(8); PG8_WAIT_L(0); PG8_BAR; PG8_MMA(0, 0, At, B0); PG8_MMA(0, 1, At, B1); PG8_BAR; PG8_SCHED;
            PG8_LDA(At, 1, 1); PG8_STAGE(PG8_SB(1, 0), b3, voffB); PG8_STAGE(PG8_SB(1, 1), b3 + hstep, voffB); PG8_STAGE(PG8_SA(1, 0), a3, voffA);
            PG8_WAIT_V(8); PG8_WAIT_L(0); PG8_BAR; PG8_MMA(1, 0, At, B0); PG8_MMA(1, 1, At, B1); PG8_BAR; PG8_SCHED;
            } else {
            PG8_LDB(B0, 0, 0); PG8_SCHED; PG8_LDA(At, 0, 0); PG8_STAGE(PG8_SA(1, 1), a1 + hstep, voffA);
            PG8_WAIT_L(8); PG8_BAR; PG8_WAIT_L(0); PG8_MMA(0, 0, At, B0); PG8_BAR; PG8_SCHED;
            PG8_LDB(B1, 0, 1); PG8_STAGE(PG8_SB(0, 0), b2, voffB);
            PG8_BAR; PG8_WAIT_L(0); PG8_MMA(0, 1, At, B1); PG8_BAR;
            PG8_LDA(At, 0, 1); PG8_STAGE(PG8_SA(0, 0), a2, voffA);
            PG8_BAR; PG8_WAIT_L(0); PG8_MMA(1, 0, At, B0); PG8_BAR; PG8_SCHED;
            PG8_STAGE(PG8_SB(0, 1), b2 + hstep, voffB);
            PG8_WAIT_V(6); PG8_BAR; PG8_MMA(1, 1, At, B1); PG8_BAR;
            PG8_LDB(B0, 1, 0); PG8_SCHED; PG8_LDA(At, 1, 0); PG8_STAGE(PG8_SA(0, 1), a2 + hstep, voffA);
            PG8_WAIT_L(8); PG8_BAR; PG8_WAIT_L(0); PG8_MMA(0, 0, At, B0); PG8_BAR; PG8_SCHED;
            PG8_LDB(B1, 1, 1); PG8_STAGE(PG8_SB(1, 0), b3, voffB);
            PG8_BAR; PG8_WAIT_L(0); PG8_MMA(0, 1, At, B1); PG8_BAR;
            PG8_LDA(At, 1, 1); PG8_STAGE(PG8_SA(1, 0), a3, voffA);
            PG8_BAR; PG8_WAIT_L(0); PG8_MMA(1, 0, At, B0); PG8_BAR; PG8_SCHED;
            PG8_STAGE(PG8_SB(1, 1), b3 + hstep, voffB);
            PG8_WAIT_V(6); PG8_BAR; PG8_MMA(1, 1, At, B1); PG8_BAR;
            }
        }
        if constexpr (ALIGN_EPI) { if (wr == 0) PG8_BAR; }
        if constexpr (!Epi::AFTER_DRAIN) { E(acc, cur, wr, wc, fr, fq); S.done(cur); }
        if (!has_next) break;
#pragma unroll
        for (int a = 0; a < 2; ++a)
#pragma unroll
            for (int b = 0; b < 2; ++b)
#pragma unroll
                for (int m = 0; m < 4; ++m)
#pragma unroll
                    for (int n = 0; n < 2; ++n) acc[a][b][m][n] = (f32x4){0.f, 0.f, 0.f, 0.f};
        cur = nxt; cA = nA; cB = nB; ++ui;
        if constexpr (ALIGN_EPI) { if (wr == 1) PG8_BAR; }
    }
    PG8_WAIT_V(0);
    if constexpr (!ALIGN_EPI) { if (wr == 0) PG8_BAR; }
    PG8_BAR;
    if constexpr (Epi::AFTER_DRAIN) { E.fused(acc, cur, wr, wc, fr, fq, lds, wid, lane); S.done(cur); }
#undef PG8_SA
#undef PG8_SB
#undef PG8_STAGE
#undef PG8_LDA
#undef PG8_LDB
#undef PG8_MMA
#undef PG8_WAIT_V
#undef PG8_WAIT_L
#undef PG8_BAR
#undef PG8_SCHED
}
}
namespace att {
using bf16 = __hip_bfloat16;
using bf16x8 = __attribute__((ext_vector_type(8))) short;
using s16x4  = __attribute__((ext_vector_type(4))) short;
using f32x16 = __attribute__((ext_vector_type(16))) float;
using u32x4  = __attribute__((ext_vector_type(4))) unsigned;
constexpr int SEQ = 4096, QROWS = 128, KVBLK = 64, LDP = 6144, LDC = 2048;
constexpr int SHM_V = KVBLK * 128 * 2, SHM_K = KVBLK * 128 * 2;
constexpr int OFF_WS = 2 * SHM_V + 2 * SHM_K;
constexpr int OFF_STG = OFF_WS + 8 * 64 * 4;
constexpr int ATT_LDS = OFF_STG + 4 * 32 * 128 * 2;
constexpr float THR = 8.f;
#ifndef ATT_SDEPTH
#define ATT_SDEPTH 1
#endif
constexpr int SDEPTH = ATT_SDEPTH;
#define KSWZ(row, colB) ((row) * 256 + ((colB) ^ (((row) & 7) << 4)))
#define SBAR() __builtin_amdgcn_sched_barrier(0)
__device__ __forceinline__ int crow(int r, int hi) { return (r & 3) + 8 * (r >> 2) + 4 * hi; }
__device__ __forceinline__ unsigned cvtpk(float lo, float hi) { unsigned r; asm volatile("v_cvt_pk_bf16_f32 %0, %1, %2" : "=v"(r) : "v"(lo), "v"(hi)); return r; }
__device__ __forceinline__ void partialSM(f32x16& p0, f32x16& p1, float& m_reg, float& mn, float& alpha) {
  float pmax = p0[0];
#pragma unroll
  for (int r = 1; r < 16; ++r) pmax = fmaxf(pmax, p0[r]);
#pragma unroll
  for (int r = 0; r < 16; ++r) pmax = fmaxf(pmax, p1[r]);
  { auto rr = __builtin_amdgcn_permlane32_swap(__float_as_uint(pmax), __float_as_uint(pmax), false, false);
    pmax = fmaxf(__uint_as_float(rr[0]), __uint_as_float(rr[1])); }
  if (__builtin_expect(__all(pmax - m_reg <= THR), 1)) { mn = m_reg; alpha = 1.f; }
  else { mn = fmaxf(m_reg, pmax); alpha = __builtin_amdgcn_exp2f(m_reg - mn); m_reg = mn; }
#pragma unroll
  for (int r = 0; r < 16; ++r) p0[r] = p0[r] - mn;
#pragma unroll
  for (int r = 0; r < 16; ++r) p1[r] = p1[r] - mn;
#pragma unroll
  for (int r = 0; r < 16; ++r) p0[r] = __builtin_amdgcn_exp2f(p0[r]);
}
__device__ __forceinline__ void finishSM(f32x16& p0, f32x16& p1, float alpha, float& l_reg, bf16x8& pa0, bf16x8& pa1, bf16x8& pa2, bf16x8& pa3) {
#pragma unroll
  for (int r = 0; r < 16; ++r) p1[r] = __builtin_amdgcn_exp2f(p1[r]);
  float ps = 0;
#pragma unroll
  for (int r = 0; r < 16; ++r) ps += p0[r];
#pragma unroll
  for (int r = 0; r < 16; ++r) ps += p1[r];
  { auto rr = __builtin_amdgcn_permlane32_swap(__float_as_uint(ps), __float_as_uint(ps), false, false);
    ps = __uint_as_float(rr[0]) + __uint_as_float(rr[1]); }
  l_reg = l_reg * alpha + ps;
#define PK4(P, BASE, OUT) do { unsigned a0 = cvtpk(P[BASE + 0], P[BASE + 1]), a1 = cvtpk(P[BASE + 2], P[BASE + 3]);   \
    unsigned b0 = cvtpk(P[BASE + 4], P[BASE + 5]), b1 = cvtpk(P[BASE + 6], P[BASE + 7]);                              \
    auto r0 = __builtin_amdgcn_permlane32_swap(a0, b0, false, false); auto r1 = __builtin_amdgcn_permlane32_swap(a1, b1, false, false); \
    u32x4 w = {r0[0], r1[0], r0[1], r1[1]}; OUT = *reinterpret_cast<bf16x8*>(&w); } while (0)
  PK4(p0, 0, pa0); PK4(p0, 8, pa1); PK4(p1, 0, pa2); PK4(p1, 8, pa3);
#undef PK4
}
__device__ __forceinline__ void qkt(f32x16& p0, f32x16& p1, const char* Ks, const bf16x8* qr, int r32, int hi, int cbase) {
  p0 = f32x16{}; p1 = f32x16{};
#pragma unroll
  for (int d0 = 0; d0 < 4; ++d0) { const int cb = cbase + (d0 * 16 + hi * 8) * 2;
    bf16x8 b0 = *reinterpret_cast<const bf16x8*>(Ks + KSWZ(r32, cb));
    bf16x8 b1 = *reinterpret_cast<const bf16x8*>(Ks + KSWZ(32 + r32, cb));
    p0 = __builtin_amdgcn_mfma_f32_32x32x16_bf16(b0, qr[d0], p0, 0, 0, 0);
    p1 = __builtin_amdgcn_mfma_f32_32x32x16_bf16(b1, qr[d0], p1, 0, 0, 0); }
}
__device__ __forceinline__ int v_st(int k, int c) { const int kk = (k & ~0xC) | ((k & 4) << 1) | ((k & 8) >> 1); return ((kk >> 3) * 4 + (c >> 5)) * 512 + ((kk & 7) * 32 + (c & 31)) * 2; }
__device__ __forceinline__ int v_rd_base(int lane) { return ((lane & 3) << 3) | (((lane >> 2) & 3) << 6) | (((lane >> 4) & 1) << 5) | (((lane >> 5) & 1) << 8); }
constexpr int v_rd_off(int d0, int ks, int half) { return d0 * 512 + ks * 4096 + half * 2048; }
template <int OFF> __device__ __forceinline__ s16x4 tr_read(int vb) {
  s16x4 r; asm volatile("ds_read_b64_tr_b16 %0, %1 offset:%2" : "=&v"(r) : "v"(vb), "i"(OFF) : "memory"); return r;
}
template <int D0> __device__ __forceinline__ void pv_one(f32x16& od, int vb, bf16x8 pa0, bf16x8 pa1, bf16x8 pa2, bf16x8 pa3) {
  const s16x4 l0 = tr_read<v_rd_off(D0, 0, 0)>(vb), h0 = tr_read<v_rd_off(D0, 0, 1)>(vb), l1 = tr_read<v_rd_off(D0, 1, 0)>(vb), h1 = tr_read<v_rd_off(D0, 1, 1)>(vb);
  const s16x4 l2 = tr_read<v_rd_off(D0, 2, 0)>(vb), h2 = tr_read<v_rd_off(D0, 2, 1)>(vb), l3 = tr_read<v_rd_off(D0, 3, 0)>(vb), h3 = tr_read<v_rd_off(D0, 3, 1)>(vb);
  asm volatile("s_waitcnt lgkmcnt(0)" ::: "memory"); SBAR();
#define PK(L, H) (bf16x8){L[0], L[1], L[2], L[3], H[0], H[1], H[2], H[3]}
  od = __builtin_amdgcn_mfma_f32_32x32x16_bf16(pa0, PK(l0, h0), od, 0, 0, 0);
  od = __builtin_amdgcn_mfma_f32_32x32x16_bf16(pa1, PK(l1, h1), od, 0, 0, 0);
  od = __builtin_amdgcn_mfma_f32_32x32x16_bf16(pa2, PK(l2, h2), od, 0, 0, 0);
  od = __builtin_amdgcn_mfma_f32_32x32x16_bf16(pa3, PK(l3, h3), od, 0, 0, 0);
#undef PK
}
__device__ __forceinline__ void pv_d0(f32x16* o, int vb, bf16x8 pa0, bf16x8 pa1, bf16x8 pa2, bf16x8 pa3) {
  pv_one<0>(o[0], vb, pa0, pa1, pa2, pa3); pv_one<1>(o[1], vb, pa0, pa1, pa2, pa3); pv_one<2>(o[2], vb, pa0, pa1, pa2, pa3); pv_one<3>(o[3], vb, pa0, pa1, pa2, pa3);
}
__device__ __forceinline__ void attn_unit(const bf16* __restrict__ proj, bf16* __restrict__ cat, int b, int h, int qb, float lam, float oscale, const float* __restrict__ subln, char* lds) {
  int tid_ = threadIdx.x; asm volatile("" : "+v"(tid_));
  const int tid = tid_, wid = tid >> 6, lane = tid & 63, r32 = lane & 31, hi = lane >> 5, rg = wid >> 1, mp = wid & 1;
  char* V_lds = lds; char* K_lds = lds + 2 * SHM_V;
  float* ws = (float*)(lds + OFF_WS) + wid * 64; float* li_l = ws; float* al_l = ws + 32;
  const long rowbase = (long)b * SEQ;
  const bf16* Kh = proj + rowbase * LDP + 1024 + h * 128; const bf16* Vh = proj + rowbase * LDP + 2048 + h * 128;
  float m_reg = -1e30f, l_reg = 0; f32x16 o[4] = {}; bf16x8 qr[4];
  const bf16* Qw = proj + (rowbase + qb * QROWS + rg * 32 + r32) * LDP + (2 * h + mp) * 64 + hi * 8;
#pragma unroll
  for (int d0 = 0; d0 < 4; ++d0) qr[d0] = *reinterpret_cast<const bf16x8*>(Qw + d0 * 16);
  const int cbase = mp * 128;
  const int sr = tid >> 4, sc = (tid & 15) * 8, vst0 = v_st(sr, sc), vst1 = v_st(32 + sr, sc);
  const int vb0 = (int)(uintptr_t)V_lds + v_rd_base(lane);
  struct { bf16x8 vs0, vs1, ks0, ks1; } sr_[SDEPTH];
#define SLOAD(i, k0) do { sr_[i].vs0 = *reinterpret_cast<const bf16x8*>(&Vh[(long)((k0) + sr) * LDP + sc]); sr_[i].vs1 = *reinterpret_cast<const bf16x8*>(&Vh[(long)((k0) + 32 + sr) * LDP + sc]); \
    sr_[i].ks0 = *reinterpret_cast<const bf16x8*>(&Kh[(long)((k0) + sr) * LDP + sc]); sr_[i].ks1 = *reinterpret_cast<const bf16x8*>(&Kh[(long)((k0) + 32 + sr) * LDP + sc]); } while (0)
#define SWRITE(bb, i) do { *(bf16x8*)(V_lds + (bb) * SHM_V + vst0) = sr_[i].vs0;          \
    *(bf16x8*)(V_lds + (bb) * SHM_V + vst1) = sr_[i].vs1; int kc = sc * 2;               \
    *(bf16x8*)(K_lds + (bb) * SHM_K + KSWZ(sr, kc)) = sr_[i].ks0;                       \
    *(bf16x8*)(K_lds + (bb) * SHM_K + KSWZ(32 + sr, kc)) = sr_[i].ks1; } while (0)
#define SWAIT() do { if constexpr (SDEPTH == 2) asm volatile("s_waitcnt vmcnt(4)" ::: "memory"); else asm volatile("s_waitcnt vmcnt(0)" ::: "memory"); } while (0)
#define RESC(a) do { if (__any((a) < 1.f)) { if (hi == 0) al_l[r32] = (a); asm volatile("s_waitcnt lgkmcnt(0)" ::: "memory"); \
    _Pragma("unroll") for (int d = 0; d < 4; ++d) _Pragma("unroll") for (int r = 0; r < 16; ++r) o[d][r] *= al_l[crow(r, hi)]; } } while (0)
  f32x16 pA0, pA1, pB0, pB1; float mnA, mnB, alA, alB; bf16x8 pa0, pa1, pa2, pa3; constexpr int NT = SEQ / KVBLK;
  constexpr int SE = 0, SO = SDEPTH - 1;
  SLOAD(SE, 0); asm volatile("s_waitcnt vmcnt(0)" ::: "memory"); SWRITE(0, SE); __syncthreads();
  qkt(pA0, pA1, K_lds, qr, r32, hi, cbase); partialSM(pA0, pA1, m_reg, mnA, alA);
  SLOAD(SO, KVBLK); if constexpr (SDEPTH == 2) SLOAD(SE, 2 * KVBLK);
  SWAIT(); SWRITE(1, SO); __syncthreads();
  for (int j = 1; j + 1 < NT; j += 2) {
    SBAR(); qkt(pB0, pB1, K_lds + SHM_K, qr, r32, hi, cbase);
    finishSM(pA0, pA1, alA, l_reg, pa0, pa1, pa2, pa3); SBAR();
    SLOAD(SO, (j + SDEPTH) * KVBLK); SBAR();
    pv_d0(o, vb0, pa0, pa1, pa2, pa3); partialSM(pB0, pB1, m_reg, mnB, alB);
    __syncthreads(); SWAIT(); SWRITE(0, SE);
    RESC(alB); __syncthreads();
    SBAR(); qkt(pA0, pA1, K_lds, qr, r32, hi, cbase);
    finishSM(pB0, pB1, alB, l_reg, pa0, pa1, pa2, pa3); SBAR();
    if (SDEPTH == 1 || j + 3 < NT) SLOAD(SE, (j + 1 + SDEPTH) * KVBLK); SBAR();
    pv_d0(o, vb0 + SHM_V, pa0, pa1, pa2, pa3); partialSM(pA0, pA1, m_reg, mnA, alA);
    __syncthreads(); SWAIT(); SWRITE(1, SO);
    RESC(alA); __syncthreads();
  }
  SBAR(); qkt(pB0, pB1, K_lds + SHM_K, qr, r32, hi, cbase);
  finishSM(pA0, pA1, alA, l_reg, pa0, pa1, pa2, pa3); SBAR();
  pv_d0(o, vb0, pa0, pa1, pa2, pa3); partialSM(pB0, pB1, m_reg, mnB, alB);
  __syncthreads(); RESC(alB);
  finishSM(pB0, pB1, alB, l_reg, pa0, pa1, pa2, pa3); SBAR();
  pv_d0(o, vb0 + SHM_V, pa0, pa1, pa2, pa3);
  if (hi == 0) li_l[r32] = l_reg; asm volatile("s_waitcnt lgkmcnt(0)" ::: "memory");
  float rli[16];
#pragma unroll
  for (int r = 0; r < 16; ++r) rli[r] = __builtin_amdgcn_rcpf(li_l[crow(r, hi)]);
  __syncthreads();
  float* X = (float*)(lds + rg * 16384);
  if (mp == 1) {
#pragma unroll
    for (int d0 = 0; d0 < 4; ++d0)
#pragma unroll
      for (int r = 0; r < 16; ++r) X[(d0 * 16 + r) * 64 + lane] = o[d0][r] * rli[r] * lam;
  }
  __syncthreads();
  if (mp == 0) {
    float g[4];
#pragma unroll
    for (int d0 = 0; d0 < 4; ++d0) g[d0] = subln[d0 * 32 + r32] * oscale;
    bf16* stg = (bf16*)(lds + OFF_STG) + rg * (32 * 128);
#pragma unroll
    for (int r = 0; r < 16; ++r) { float s = 0.f;
#pragma unroll
      for (int d0 = 0; d0 < 4; ++d0) { const float v = o[d0][r] * rli[r] - X[(d0 * 16 + r) * 64 + lane]; o[d0][r] = v; s += v * v; }
      s += __shfl_xor(s, 1); s += __shfl_xor(s, 2); s += __shfl_xor(s, 4); s += __shfl_xor(s, 8); s += __shfl_xor(s, 16);
      const float rs = __builtin_amdgcn_rsqf(s * (1.f / 128.f) + 1e-6f); const int orow = crow(r, hi);
#pragma unroll
      for (int d0 = 0; d0 < 4; ++d0) stg[orow * 128 + d0 * 32 + r32] = __float2bfloat16(o[d0][r] * rs * g[d0]); }
    asm volatile("s_waitcnt lgkmcnt(0)" ::: "memory");
    bf16* Ow = cat + (rowbase + qb * QROWS + rg * 32) * LDC + h * 128;
#pragma unroll
    for (int i = 0; i < 8; ++i) { const int row = i * 4 + (lane >> 4), ch = lane & 15; const u32x4 v = *(const u32x4*)(stg + row * 128 + ch * 8); *(u32x4*)(Ow + (long)row * LDC + ch * 8) = v; }
  }
  __syncthreads();
#undef SLOAD
#undef SWRITE
#undef SWAIT
#undef RESC
}
__device__ __forceinline__ void conv_rows(const bf16* __restrict__ proj, bf16* __restrict__ cat, const float* __restrict__ cw, int row0) {
  int tid_ = threadIdx.x; asm volatile("" : "+v"(tid_));
  const int tid = tid_, cg8 = (tid & 127) * 8, rs = tid >> 7, r0 = row0 + rs * 16;
  float w0[8], w1[8], w2[8];
#pragma unroll
  for (int e = 0; e < 8; ++e) { w0[e] = cw[cg8 + e]; w1[e] = cw[1024 + cg8 + e]; w2[e] = cw[2048 + cg8 + e]; }
  auto ldz = [&](int row, float* z) {
    const bf16x8 c = *reinterpret_cast<const bf16x8*>(proj + (long)row * LDP + 4096 + cg8), u = *reinterpret_cast<const bf16x8*>(proj + (long)row * LDP + 5120 + cg8);
#pragma unroll
    for (int e = 0; e < 8; ++e) z[e] = __uint_as_float(((unsigned)(unsigned short)c[e]) << 16) * __uint_as_float(((unsigned)(unsigned short)u[e]) << 16);
  };
  float zp[8], zc[8], zn[8];
  if ((r0 & (SEQ - 1)) == 0) {
#pragma unroll
    for (int e = 0; e < 8; ++e) zp[e] = 0.f;
  } else ldz(r0 - 1, zp);
  ldz(r0, zc);
#pragma unroll 4
  for (int i = 0; i < 16; ++i) { const int row = r0 + i;
    if (((row + 1) & (SEQ - 1)) == 0) {
#pragma unroll
      for (int e = 0; e < 8; ++e) zn[e] = 0.f;
    } else ldz(row + 1, zn);
    const bf16x8 gb = *reinterpret_cast<const bf16x8*>(proj + (long)row * LDP + 3072 + cg8);
    float y[8];
#pragma unroll
    for (int e = 0; e < 8; ++e) y[e] = __uint_as_float(((unsigned)(unsigned short)gb[e]) << 16) * (zp[e] * w0[e] + zc[e] * w1[e] + zn[e] * w2[e]);
    u32x4 w; w.x = cvtpk(y[0], y[1]); w.y = cvtpk(y[2], y[3]); w.z = cvtpk(y[4], y[5]); w.w = cvtpk(y[6], y[7]);
    *(u32x4*)(cat + (long)row * LDC + 1024 + cg8) = w;
#pragma unroll
    for (int e = 0; e < 8; ++e) { zp[e] = zc[e]; zc[e] = zn[e]; }
  }
}
#undef SBAR
}
constexpr int NWAVES = 8;
constexpr int DM = 2048, BATCH = 4, SEQ = 4096, DEPTH = 4, M = BATCH * SEQ, NIN = 6144, DFF = 5632, NGU = 2 * DFF;
constexpr float EPS = 1e-6f;
constexpr size_t MiB = 1u << 20;
constexpr size_t WS_CTL = 0, CTL_ZERO_BYTES = 1 * MiB;
constexpr size_t WS_ROPE = 1 * MiB;
constexpr size_t WS_WIN = 2 * MiB, WS_WOUT = 98 * MiB, WS_WGU = 130 * MiB, WS_WDN = 306 * MiB;
constexpr size_t WS_XN = 394 * MiB, WS_PROJ = 458 * MiB, WS_CAT = 650 * MiB, WS_HID = 458 * MiB, WS_END = 714 * MiB;
constexpr int LDS_BYTES = 147456;
#define LAS __attribute__((address_space(3)))
typedef unsigned short bf16;
typedef unsigned v4u __attribute__((ext_vector_type(4)));
typedef float f32x4 __attribute__((ext_vector_type(4)));
__device__ __forceinline__ unsigned f2bf(float f) { unsigned u = __builtin_bit_cast(unsigned, f); return (u + 0x7fffu + ((u >> 16) & 1u)) >> 16; }
__device__ __forceinline__ unsigned pk2(float lo, float hi) { return f2bf(lo) | (f2bf(hi) << 16); }
__device__ __forceinline__ float wave_sum(float v) {
#pragma unroll
    for (int o = 1; o < 64; o <<= 1) v += __shfl_xor(v, o);
    return v;
}
__device__ __forceinline__ void p0_transpose_item(const float* __restrict__ W, int K, int N, bf16* __restrict__ WT, int dst_row0, int k0, int n0, LAS float* scr, int lane) {
#pragma unroll 8
    for (int i = 0; i < 32; ++i) { const int kk = 2 * i + (lane >> 5); scr[kk * 33 + (lane & 31)] = W[(size_t)(k0 + kk) * N + n0 + (lane & 31)]; }
    asm volatile("s_waitcnt lgkmcnt(0)" ::: "memory");
    const int c = lane & 7;
#pragma unroll
    for (int j = 0; j < 4; ++j) { const int n = (lane >> 3) + 8 * j; const LAS float* s = scr + (8 * c) * 33 + n;
        v4u o; o.x = pk2(s[0 * 33], s[1 * 33]); o.y = pk2(s[2 * 33], s[3 * 33]); o.z = pk2(s[4 * 33], s[5 * 33]); o.w = pk2(s[6 * 33], s[7 * 33]);
        *(v4u*)(WT + (size_t)(dst_row0 + n) * K + k0 + 8 * c) = o; }
    asm volatile("s_waitcnt lgkmcnt(0)" ::: "memory");
}
struct Args { const float* in[15]; float* out; unsigned char* ws; float lam_init[4]; int pad[2]; };

__device__ __forceinline__ void norm_rows_bf16(const float* __restrict__ x, const float* __restrict__ g, bf16* __restrict__ xn, int gw, int NGW, int lane) {
    asm volatile("" : "+v"(lane));
    f32x4 gv[8];
#pragma unroll
    for (int j = 0; j < 8; ++j) gv[j] = ((const f32x4*)g)[lane + 64 * j];
    for (int m = gw; m < M; m += NGW) {
        const f32x4* xr = (const f32x4*)(x + (size_t)m * DM) + lane; f32x4 v[8]; float s = 0.f;
#pragma unroll
        for (int j = 0; j < 8; ++j) { v[j] = xr[64 * j]; s += (v[j].x * v[j].x + v[j].y * v[j].y) + (v[j].z * v[j].z + v[j].w * v[j].w); }
        const float rstd = 1.0f / sqrtf(wave_sum(s) * (1.f / DM) + EPS);
        unsigned long long* o8 = (unsigned long long*)(xn + (size_t)m * DM) + lane;
#pragma unroll
        for (int j = 0; j < 8; ++j) o8[64 * j] = (unsigned long long)pk2(v[j].x * rstd * gv[j].x, v[j].y * rstd * gv[j].y) | ((unsigned long long)pk2(v[j].z * rstd * gv[j].z, v[j].w * rstd * gv[j].w) << 32);
    }
}
__device__ __forceinline__ void norm_rows_f32(float* x, const float* __restrict__ g, int gw, int NGW, int lane) {
    asm volatile("" : "+v"(lane));
    f32x4 gv[8];
#pragma unroll
    for (int j = 0; j < 8; ++j) gv[j] = ((const f32x4*)g)[lane + 64 * j];
    for (int m = gw; m < M; m += NGW) {
        f32x4* xr = (f32x4*)(x + (size_t)m * DM) + lane; f32x4 v[8]; float s = 0.f;
#pragma unroll
        for (int j = 0; j < 8; ++j) { v[j] = xr[64 * j]; s += (v[j].x * v[j].x + v[j].y * v[j].y) + (v[j].z * v[j].z + v[j].w * v[j].w); }
        const float rstd = 1.0f / sqrtf(wave_sum(s) * (1.f / DM) + EPS);
#pragma unroll
        for (int j = 0; j < 8; ++j) xr[64 * j] = v[j] * rstd * gv[j];
    }
}

__global__ void __launch_bounds__(NWAVES * 64, 2) fwd_megakernel(Args args) {
    extern __shared__ __attribute__((aligned(16))) unsigned char lds[];
    cg::grid_group grid = cg::this_grid();
    const int tid = threadIdx.x, lane = tid & 63, wave = __builtin_amdgcn_readfirstlane(tid >> 6);
    const int G = gridDim.x, bx = blockIdx.x, vcu = (G % 8 == 0) ? (bx % 8) * (G / 8) + bx / 8 : bx;
    const int gw = vcu * NWAVES + wave, NGW = G * NWAVES;
    unsigned char* ws = args.ws;
    const float* x_in = args.in[0]; const float* norm_mix = args.in[1]; const float* w_in = args.in[2];
    const float* lq1 = args.in[3]; const float* lk1 = args.in[4]; const float* lq2 = args.in[5]; const float* lk2 = args.in[6];
    const float* subln = args.in[7]; const float* conv_w = args.in[8]; const float* w_out = args.in[9]; const float* norm_ffn = args.in[10];
    const float* w_gate = args.in[11]; const float* w_up = args.in[12]; const float* w_down = args.in[13]; const float* norm_final = args.in[14];
    float* out = args.out;
    float* cosT = (float*)(ws + WS_ROPE); float* sinT = cosT + 4096 * 32;
    bf16* Win_t = (bf16*)(ws + WS_WIN); bf16* Wout_t = (bf16*)(ws + WS_WOUT); bf16* Wgu_t = (bf16*)(ws + WS_WGU); bf16* Wdn_t = (bf16*)(ws + WS_WDN);
    bf16* XN = (bf16*)(ws + WS_XN); bf16* PROJ = (bf16*)(ws + WS_PROJ); bf16* CAT = (bf16*)(ws + WS_CAT); bf16* HID = (bf16*)(ws + WS_HID);
    LAS unsigned char* ldsl = (LAS unsigned char*)lds;

    {
        LAS float* scr = (LAS float*)(ldsl + wave * 16384);
        constexpr int I_IN = (DM / 64) * (NIN / 32), I_OUT = (DM / 64) * (DM / 32), I_G = (DM / 64) * (DFF / 32), I_D = (DFF / 64) * (DM / 32);
        constexpr int I_LAYER = I_IN + I_OUT + 2 * I_G + I_D, NITEMS = DEPTH * I_LAYER;
        for (int it = gw; it < NITEMS; it += NGW) {
            const int l = it / I_LAYER; int r = it % I_LAYER;
            if (r < I_IN) { const int nblk = NIN / 32, kb = r / nblk, nb = r % nblk, c0 = nb * 32; int d0 = c0;
                if (c0 < 2048) d0 = (c0 & ~255) + 128 * ((c0 >> 5) & 1) + 32 * ((c0 >> 6) & 3);
                p0_transpose_item(w_in + (size_t)l * DM * NIN, DM, NIN, Win_t + (size_t)l * NIN * DM, d0, kb * 64, c0, scr, lane); continue; }
            r -= I_IN;
            if (r < I_OUT) { const int nblk = DM / 32, kb = r / nblk, nb = r % nblk;
                p0_transpose_item(w_out + (size_t)l * DM * DM, DM, DM, Wout_t + (size_t)l * DM * DM, nb * 32, kb * 64, nb * 32, scr, lane); continue; }
            r -= I_OUT;
            if (r < 2 * I_G) { const int up = r >= I_G; if (up) r -= I_G; const int nblk = DFF / 32, kb = r / nblk, nb = r % nblk, c0 = nb * 32;
                const int d0 = (c0 >> 7) * 256 + up * 128 + (c0 & 127);
                p0_transpose_item((up ? w_up : w_gate) + (size_t)l * DM * DFF, DM, DFF, Wgu_t + (size_t)l * NGU * DM, d0, kb * 64, c0, scr, lane); continue; }
            r -= 2 * I_G;
            { const int nblk = DM / 32, kb = r / nblk, nb = r % nblk;
                p0_transpose_item(w_down + (size_t)l * DFF * DM, DFF, DM, Wdn_t + (size_t)l * DM * DFF, nb * 32, kb * 64, nb * 32, scr, lane); }
        }
        for (int i = bx * (NWAVES * 64) + tid; i < 4096 * 32; i += G * NWAVES * 64) {
            const int pos = i >> 5, j = i & 31;
            const float inv_freq = (float)exp2(-(double)j * (13.287712379549449 / 32.0));
            const float ang = (float)pos * inv_freq;
            const double t = (double)ang, kq = rint(t * 0.63661977236758134), y = t - kq * 1.5707963267948966, y2 = y * y;
            const double sn = y * (1.0 + y2 * (-1.0 / 6 + y2 * (1.0 / 120 + y2 * (-1.0 / 5040 + y2 * (1.0 / 362880 + y2 * (-1.0 / 39916800 + y2 * (1.0 / 6227020800.0 + y2 * (-1.0 / 1307674368000.0))))))));
            const double cs = 1.0 + y2 * (-0.5 + y2 * (1.0 / 24 + y2 * (-1.0 / 720 + y2 * (1.0 / 40320 + y2 * (-1.0 / 3628800 + y2 * (1.0 / 479001600.0 + y2 * (-1.0 / 87178291200.0 + y2 * (1.0 / 20922789888000.0))))))));
            const int q = (int)((long long)kq & 3);
            const double sv = (q == 0) ? sn : (q == 1) ? cs : (q == 2) ? -sn : -cs, cv = (q == 0) ? cs : (q == 1) ? -sn : (q == 2) ? -cs : sn;
            cosT[i] = (float)cv; sinT[i] = (float)sv;
        }
    }
    grid.sync();

#pragma unroll 1
    for (int l = 0; l < DEPTH; ++l) {
        const float* xcur = (l == 0) ? x_in : out;
        norm_rows_bf16(xcur, norm_mix + l * DM, XN, gw, NGW, lane);
        grid.sync();
#ifndef NO_G1
        { pg8::Gemm g{XN, Win_t + (size_t)l * NIN * DM, M, NIN, DM}; pg8::StaticOrder S; S.init(M, NIN, G, bx);
          pg8::EpiInProj E{PROJ, NIN, cosT, sinT, nullptr, 1.f / DM, EPS};
          pg8::gemm_phase<pg8::EpiInProj, pg8::StaticOrder, true, true>(ldsl, g, S, E); }
#endif
        grid.sync();
        {
            float lam;
            { const float a = wave_sum(lq1[l * 64 + lane] * lk1[l * 64 + lane]), b2 = wave_sum(lq2[l * 64 + lane] * lk2[l * 64 + lane]);
              lam = expf(a) - expf(b2) + args.lam_init[l]; }
            const float oscale = 1.0f - args.lam_init[l];
            const int xcd = vcu >> 5, jq = vcu & 31;
#ifndef NO_AT
            for (int i = 0; ; ++i) { int bh, qb;
                if (G == 256) { if (i >= 4) break; bh = xcd * 4 + i; qb = jq; } else { const int u = bx + i * G; if (u >= 1024) break; bh = u >> 5; qb = u & 31; }
                att::attn_unit((const att::bf16*)PROJ, (att::bf16*)CAT, bh >> 3, bh & 7, qb, lam, oscale, subln + l * 128, (char*)lds); }
#endif
#ifndef NO_CONV
            for (int rb = bx; rb < M / 64; rb += G) att::conv_rows((const att::bf16*)PROJ, (att::bf16*)CAT, conv_w + l * 3 * 1024, rb * 64);
#endif
        }
        grid.sync();
#ifndef NO_G2
        { pg8::Gemm g{CAT, Wout_t + (size_t)l * DM * DM, M, DM, DM}; pg8::StaticOrder S; S.init(M, DM, G, bx);
          pg8::EpiResid E{xcur, out, DM, nullptr, nullptr};
          pg8::gemm_phase<pg8::EpiResid, pg8::StaticOrder, true, true>(ldsl, g, S, E); }
#endif
        grid.sync();
        norm_rows_bf16(out, norm_ffn + l * DM, XN, gw, NGW, lane);
        grid.sync();
#ifndef NO_G3
        { pg8::Gemm g{XN, Wgu_t + (size_t)l * NGU * DM, M, NGU, DM}; pg8::StaticOrder S; S.init(M, NGU, G, bx);
          pg8::EpiSwiGLU E{HID, DFF, nullptr, 1.f / DM, EPS};
          pg8::gemm_phase<pg8::EpiSwiGLU, pg8::StaticOrder, true, true>(ldsl, g, S, E); }
#endif
        grid.sync();
#ifndef NO_G4
        { pg8::Gemm g{HID, Wdn_t + (size_t)l * DM * DFF, M, DM, DFF}; pg8::StaticOrder S; S.init(M, DM, G, bx);
          pg8::EpiResid E{out, out, DM, nullptr, nullptr};
          pg8::gemm_phase<pg8::EpiResid, pg8::StaticOrder, true, true>(ldsl, g, S, E); }
#endif
        grid.sync();
    }
    norm_rows_f32(out, norm_final, gw, NGW, lane);
}

extern "C" void kernel_launch(void* const* d_in, const int* in_sizes, int n_in, void* d_out, int out_size, void* d_ws, size_t ws_size, hipStream_t stream) {
    static int grid = 0;
    if (grid == 0) {
        if (n_in != 15 || in_sizes[0] != M * DM || out_size != M * DM || ws_size < WS_END) {
            fprintf(stderr, "kernel_launch: unexpected shapes: n_in %d in0 %d out %d ws %zu (need >= %zu)\n", n_in, n_in > 0 ? in_sizes[0] : -1, out_size, ws_size, (size_t)WS_END); grid = -1; return; }
        int dev = 0, cus = 0, per_cu = 0;
        if (hipGetDevice(&dev) != hipSuccess || hipDeviceGetAttribute(&cus, hipDeviceAttributeMultiprocessorCount, dev) != hipSuccess) { grid = -1; return; }
        if (hipFuncSetAttribute((const void*)fwd_megakernel, hipFuncAttributeMaxDynamicSharedMemorySize, LDS_BYTES) != hipSuccess) { fprintf(stderr, "kernel_launch: hipFuncSetAttribute failed\n"); grid = -1; return; }
        if (hipOccupancyMaxActiveBlocksPerMultiprocessor(&per_cu, (const void*)fwd_megakernel, NWAVES * 64, LDS_BYTES) != hipSuccess || per_cu < 1) { fprintf(stderr, "kernel_launch: occupancy query says %d\n", per_cu); per_cu = 1; }
        (void)hipGetLastError();
        grid = cus * 1;
    }
    if (grid < 0) return;
    Args a{};
    for (int i = 0; i < 15; ++i) a.in[i] = (const float*)d_in[i];
    a.out = (float*)d_out; a.ws = (unsigned char*)d_ws;
    for (int l = 0; l < 4; ++l) a.lam_init[l] = (float)(0.8 - 0.6 * std::exp(-0.3 * (double)l));
    void* kargs[] = {&a};
    hipError_t e = hipLaunchCooperativeKernel((const void*)fwd_megakernel, dim3(grid), dim3(NWAVES * 64), kargs, LDS_BYTES, stream);
    if (e != hipSuccess) fprintf(stderr, "kernel_launch: cooperative launch failed: %s (grid %d)\n", hipGetErrorString(e), grid);
}
```

```cpp
#include <hip/hip_runtime.h>
#include <hip/hip_cooperative_groups.h>
#include <hip/hip_bf16.h>
#include <cstdio>
#include <cstdint>
#include <cmath>
namespace cg = cooperative_groups;
namespace pg8 {
#define PG8_LAS __attribute__((address_space(3)))
typedef unsigned short bf16_t;
typedef short bf16x8 __attribute__((ext_vector_type(8)));
typedef float f32x4 __attribute__((ext_vector_type(4)));
typedef unsigned u32x4 __attribute__((ext_vector_type(4)));
constexpr int BM = 256, BK = 64, HALF = 128, HTB = HALF * BK * 2  , STAGE_BYTES = 8 * HTB, NXCD = 8, WGM = 8;

__host__ __device__ __forceinline__ int lds_byte(int r, int c) { const int st = (r >> 4) * 2 + (c >> 5), rr = r & 15, cc = c & 31, ob = rr * 64 + cc * 2; return st * 1024 + (ob ^ (((ob >> 9) & 1) << 5)); }
__host__ __device__ __forceinline__ void stage_rc(int b, int& R, int& C) { const int st = b / 1024, sb = b % 1024, swz = sb ^ (((sb >> 9) & 1) << 5); R = (st >> 1) * 16 + swz / 64; C = (st & 1) * 32 + (swz % 64) / 2; }
__host__ __device__ __forceinline__ int perm32(int rho) { const int n = rho >> 4, i = rho & 15; return 8 * (i >> 2) + 4 * n + (i & 3); }

struct Unit { int pm, pn; };
struct Gemm { const bf16_t* A; const bf16_t* Bt; int M, N, K; };

struct StaticOrder {
    int nM, nN, nwg, G, c;
    __host__ __device__ void init(int M, int N, int G_, int c_) { nM = M / BM; nN = N / BM; nwg = nM * nN; G = G_; c = c_; }
    __host__ __device__ bool next(int i, Unit& u) const {
        const long L = (long)i * G + c; if (L >= nwg) return false;
        int wgid = (int)L; { const int q = nwg / NXCD, r = nwg % NXCD, xcd = wgid % NXCD, off = wgid / NXCD; wgid = (xcd < r ? xcd * (q + 1) : r * (q + 1) + (xcd - r) * q) + off; }
        const int nig = WGM * nN, gid = wgid / nig, fm = gid * WGM, gsz = (nM - fm) < WGM ? (nM - fm) : WGM;
        u.pm = fm + ((wgid % nig) % gsz); u.pn = (wgid % nig) / gsz; return true;
    }
    __device__ __forceinline__ void a_ready(const Unit&) const {}
    __device__ __forceinline__ void done(const Unit&) const {}
};

__device__ __forceinline__ unsigned cvt_pk_bf16(float lo, float hi) { unsigned r; asm volatile("v_cvt_pk_bf16_f32 %0, %1, %2" : "=v"(r) : "v"(lo), "v"(hi)); return r; }
typedef float f32x2 __attribute__((ext_vector_type(2)));
typedef unsigned u32x2 __attribute__((ext_vector_type(2)));
constexpr float QSCALE = 0.125f * 1.4426950408889634f;

struct EpiInProj {
    static constexpr bool PERM = true, AFTER_DRAIN = false;
    bf16_t* O; int ldc; const float* cosT; const float* sinT; const PG8_LAS float* rstd;
    __device__ __forceinline__ void operator()(const f32x4 (&acc)[2][2][4][2], const Unit& u, int wr, int wc, int fr, int fq) const {
        const int row0 = u.pm * BM + wr * 64 + fr;
        if (u.pn < 8) {
            const float sc = (u.pn < 4) ? QSCALE : 1.f;
            const int col = u.pn * BM + 64 * wc + 8 * fq;
#pragma unroll
            for (int ai = 0; ai < 2; ++ai)
#pragma unroll
                for (int m = 0; m < 4; ++m) { const int row = row0 + ai * HALF + m * 16; const int pos = row & 4095;
                    const float rs = sc * rstd[row & 255];
                    const f32x4 c0 = *(const f32x4*)(cosT + pos * 32 + 8 * fq), c1 = *(const f32x4*)(cosT + pos * 32 + 8 * fq + 4);
                    const f32x4 s0 = *(const f32x4*)(sinT + pos * 32 + 8 * fq), s1 = *(const f32x4*)(sinT + pos * 32 + 8 * fq + 4);
                    const f32x4 a0 = acc[ai][0][m][0], a1 = acc[ai][0][m][1], b0 = acc[ai][1][m][0], b1 = acc[ai][1][m][1];
                    const f32x4 x0 = (a0 * c0 - b0 * s0) * rs, x1 = (a1 * c1 - b1 * s1) * rs, y0 = (b0 * c0 + a0 * s0) * rs, y1 = (b1 * c1 + a1 * s1) * rs;
                    bf16_t* rowp = O + (size_t)row * ldc + col;
                    u32x4 w; w.x = cvt_pk_bf16(x0[0], x0[1]); w.y = cvt_pk_bf16(x0[2], x0[3]); w.z = cvt_pk_bf16(x1[0], x1[1]); w.w = cvt_pk_bf16(x1[2], x1[3]);
                    *(u32x4*)rowp = w;
                    w.x = cvt_pk_bf16(y0[0], y0[1]); w.y = cvt_pk_bf16(y0[2], y0[3]); w.z = cvt_pk_bf16(y1[0], y1[1]); w.w = cvt_pk_bf16(y1[2], y1[3]);
                    *(u32x4*)(rowp + 32) = w; }
        } else if (u.pn >= 16) {
            const int col0 = 4096 + (u.pn - 16) * HALF + wc * 32 + 8 * fq;
#pragma unroll
            for (int ai = 0; ai < 2; ++ai)
#pragma unroll
                for (int m = 0; m < 4; ++m) { const int row = row0 + ai * HALF + m * 16; const float rs = rstd[row & 255], rs2 = rs * rs;
                    const f32x4 z0 = acc[ai][0][m][0] * acc[ai][1][m][0] * rs2, z1 = acc[ai][0][m][1] * acc[ai][1][m][1] * rs2;
                    u32x4 w; w.x = cvt_pk_bf16(z0[0], z0[1]); w.y = cvt_pk_bf16(z0[2], z0[3]); w.z = cvt_pk_bf16(z1[0], z1[1]); w.w = cvt_pk_bf16(z1[2], z1[3]);
                    *(u32x4*)(O + (size_t)row * ldc + col0) = w; }
        } else {
            const int col0 = u.pn * BM + wc * 32 + 8 * fq;
#pragma unroll
            for (int ai = 0; ai < 2; ++ai)
#pragma unroll
                for (int m = 0; m < 4; ++m) { const int row = row0 + ai * HALF + m * 16; bf16_t* rowp = O + (size_t)row * ldc + col0;
                    const float rs = rstd[row & 255];
#pragma unroll
                    for (int bj = 0; bj < 2; ++bj) { const f32x4 v0 = acc[ai][bj][m][0] * rs, v1 = acc[ai][bj][m][1] * rs;
                        u32x4 w; w.x = cvt_pk_bf16(v0[0], v0[1]); w.y = cvt_pk_bf16(v0[2], v0[3]); w.z = cvt_pk_bf16(v1[0], v1[1]); w.w = cvt_pk_bf16(v1[2], v1[3]);
                        *(u32x4*)(rowp + bj * HALF) = w; } }
        }
    }
};
__device__ __forceinline__ float bf_lo(unsigned w) { return __uint_as_float(w << 16); }
__device__ __forceinline__ float bf_hi(unsigned w) { return __uint_as_float(w & 0xffff0000u); }
struct EpiResid {
    static constexpr bool PERM = true, AFTER_DRAIN = false;
    bf16_t* xb; int ldc; float* part;
    __device__ __forceinline__ void operator()(const f32x4 (&acc)[2][2][4][2], const Unit& u, int wr, int wc, int fr, int fq) const {
        const int row0 = u.pm * BM + wr * 64 + fr, col0 = u.pn * BM + wc * 32 + 8 * fq;
#pragma unroll
        for (int ai = 0; ai < 2; ++ai) {
            u32x4 xr[4][2];
#pragma unroll
            for (int m = 0; m < 4; ++m)
#pragma unroll
                for (int bj = 0; bj < 2; ++bj) xr[m][bj] = *(const u32x4*)(xb + (size_t)(row0 + ai * HALF + m * 16) * ldc + col0 + bj * HALF);
            asm volatile("" : "+v"(xr[0][0]), "+v"(xr[0][1]), "+v"(xr[1][0]), "+v"(xr[1][1]), "+v"(xr[2][0]), "+v"(xr[2][1]), "+v"(xr[3][0]), "+v"(xr[3][1]));
#pragma unroll
            for (int m = 0; m < 4; ++m) { const int row = row0 + ai * HALF + m * 16; const size_t off = (size_t)row * ldc + col0; float s = 0.f;
#pragma unroll
                for (int bj = 0; bj < 2; ++bj) { const u32x4 b = xr[m][bj];
                    const f32x4 v0 = (f32x4){bf_lo(b.x), bf_hi(b.x), bf_lo(b.y), bf_hi(b.y)} + acc[ai][bj][m][0], v1 = (f32x4){bf_lo(b.z), bf_hi(b.z), bf_lo(b.w), bf_hi(b.w)} + acc[ai][bj][m][1];
                    u32x4 w; w.x = cvt_pk_bf16(v0[0], v0[1]); w.y = cvt_pk_bf16(v0[2], v0[3]); w.z = cvt_pk_bf16(v1[0], v1[1]); w.w = cvt_pk_bf16(v1[2], v1[3]); *(u32x4*)(xb + off + bj * HALF) = w;
                    s += (v0[0] * v0[0] + v0[1] * v0[1]) + (v0[2] * v0[2] + v0[3] * v0[3]) + (v1[0] * v1[0] + v1[1] * v1[1]) + (v1[2] * v1[2] + v1[3] * v1[3]); }
                s += __shfl_xor(s, 16); s += __shfl_xor(s, 32); if (fq == 0) part[((size_t)u.pm * 32 + u.pn * 4 + wc) * 256 + (row & 255)] = s; }
        }
    }
};
struct EpiSwiGLU {
    static constexpr bool PERM = true, AFTER_DRAIN = false;
    bf16_t* O; int ldc; const PG8_LAS float* rstd;
    __device__ __forceinline__ void operator()(const f32x4 (&acc)[2][2][4][2], const Unit& u, int wr, int wc, int fr, int fq) const {
        const int row0 = u.pm * BM + wr * 64 + fr, col0 = u.pn * HALF + wc * 32 + 8 * fq;
#pragma unroll
        for (int ai = 0; ai < 2; ++ai)
#pragma unroll
            for (int m = 0; m < 4; ++m) { const int row = row0 + ai * HALF + m * 16;
                const float rs = rstd[row & 255];
                float h[8];
#pragma unroll
                for (int n = 0; n < 2; ++n)
#pragma unroll
                    for (int e = 0; e < 4; ++e) { const float g = acc[ai][0][m][n][e] * rs, up = acc[ai][1][m][n][e] * rs;
                        h[n * 4 + e] = g * up * __builtin_amdgcn_rcpf(1.f + __builtin_amdgcn_exp2f(-1.4426950408889634f * g)); }
                u32x4 w; w.x = cvt_pk_bf16(h[0], h[1]); w.y = cvt_pk_bf16(h[2], h[3]); w.z = cvt_pk_bf16(h[4], h[5]); w.w = cvt_pk_bf16(h[6], h[7]);
                *(u32x4*)(O + (size_t)row * ldc + col0) = w; }
    }
};
template <class Epi, class Sched, bool ALIGN_EPI = false, bool SP2 = false>
__device__ __forceinline__ void gemm_phase(PG8_LAS unsigned char* lds, const Gemm g, const Sched& S, const Epi& E) {
    int tid_ = threadIdx.x; asm volatile("" : "+v"(tid_));
    const int tid = tid_, wid = __builtin_amdgcn_readfirstlane(tid >> 6), lane = tid & 63, wr = wid >> 2, wc = wid & 3, fr = lane & 15, fq = lane >> 4;
    const int K = g.K, nt = K / BK;
    unsigned voffA[2], voffB[2];
#pragma unroll
    for (int i = 0; i < 2; ++i) { int R, C; stage_rc(tid * 16 + i * 8192, R, C); const int Rb = Epi::PERM ? ((R & ~31) + perm32(R & 31)) : R;
        voffA[i] = (unsigned)(R * K + C) * 2u; voffB[i] = (unsigned)(Rb * K + C) * 2u; }
    const size_t kstep = (size_t)(BK * 2);
    const size_t hstep = (size_t)HALF * K * 2;
    const size_t tstep = 2 * hstep;
    const unsigned ldsw = (unsigned)wid * 1024u;
    const int aoff = lds_byte(wr * 64 + fr, fq * 8), boff = lds_byte(wc * 32 + fr, fq * 8);
#define PG8_SA(b, h) (((b) * 2 + (h)) * HTB)
#define PG8_SB(b, h) ((4 + (b) * 2 + (h)) * HTB)
#define PG8_STAGE(bufoff, gbase, voff) do { _Pragma("unroll") for (int _i = 0; _i < 2; ++_i) \
        __builtin_amdgcn_global_load_lds((const unsigned*)((const char*)(gbase) + (voff)[_i]), (PG8_LAS unsigned*)(lds + (bufoff) + ldsw + _i * 8192), 16, 0, 0); } while (0)
#define PG8_LDA(dst, b, h) do { _Pragma("unroll") for (int m = 0; m < 4; ++m) _Pragma("unroll") for (int k = 0; k < 2; ++k) dst[m][k] = *(const PG8_LAS bf16x8*)(lds + PG8_SA(b, h) + aoff + m * 2048 + k * 1024); } while (0)
#define PG8_LDB(dst, b, h) do { _Pragma("unroll") for (int n = 0; n < 2; ++n) _Pragma("unroll") for (int k = 0; k < 2; ++k) dst[n][k] = *(const PG8_LAS bf16x8*)(lds + PG8_SB(b, h) + boff + n * 2048 + k * 1024); } while (0)
#define PG8_MMA(ai, bj, At, Bt) do { __builtin_amdgcn_s_setprio(1); _Pragma("unroll") for (int m = 0; m < 4; ++m) _Pragma("unroll") for (int n = 0; n < 2; ++n) _Pragma("unroll") for (int k = 0; k < 2; ++k) \
        acc[ai][bj][m][n] = __builtin_amdgcn_mfma_f32_16x16x32_bf16(Bt[n][k], At[m][k], acc[ai][bj][m][n], 0, 0, 0); __builtin_amdgcn_s_setprio(0); } while (0)
#define PG8_WAIT_V(n) asm volatile("s_waitcnt vmcnt(" #n ")" ::: "memory")
#define PG8_WAIT_L(n) asm volatile("s_waitcnt lgkmcnt(" #n ")" ::: "memory")
#define PG8_BAR __builtin_amdgcn_s_barrier()
#define PG8_SCHED __builtin_amdgcn_sched_barrier(0)
    Unit cur, nxt; int ui = 0;
    if (!S.next(0, cur)) return;
    f32x4 acc[2][2][4][2];
#pragma unroll
    for (int a = 0; a < 2; ++a)
#pragma unroll
        for (int b = 0; b < 2; ++b)
#pragma unroll
            for (int m = 0; m < 4; ++m)
#pragma unroll
                for (int n = 0; n < 2; ++n) acc[a][b][m][n] = (f32x4){0.f, 0.f, 0.f, 0.f};
    bf16x8 At[4][2], B0[2][2], B1[2][2];
    const char* cA = (const char*)g.A + (size_t)cur.pm * tstep; const char* cB = (const char*)g.Bt + (size_t)cur.pn * tstep;
    S.a_ready(cur);
    if constexpr (SP2) {
        PG8_STAGE(PG8_SB(0, 0), cB, voffB); PG8_STAGE(PG8_SB(0, 1), cB + hstep, voffB); PG8_STAGE(PG8_SA(0, 0), cA, voffA); PG8_STAGE(PG8_SA(0, 1), cA + hstep, voffA);
        if (wr == 1) PG8_BAR;
        PG8_WAIT_V(2); PG8_BAR;
        PG8_STAGE(PG8_SB(1, 0), cB + kstep, voffB); PG8_STAGE(PG8_SA(1, 0), cA + kstep, voffA); PG8_STAGE(PG8_SB(1, 1), cB + hstep + kstep, voffB);
        PG8_WAIT_V(6); PG8_BAR;
    } else {
        PG8_STAGE(PG8_SB(0, 0), cB, voffB); PG8_STAGE(PG8_SA(0, 0), cA, voffA); PG8_STAGE(PG8_SB(0, 1), cB + hstep, voffB); PG8_STAGE(PG8_SA(0, 1), cA + hstep, voffA);
        if (wr == 1) PG8_BAR;
        PG8_WAIT_V(4); PG8_BAR;
        PG8_STAGE(PG8_SB(1, 0), cB + kstep, voffB); PG8_STAGE(PG8_SA(1, 0), cA + kstep, voffA); PG8_STAGE(PG8_SB(1, 1), cB + hstep + kstep, voffB);
        PG8_WAIT_V(6); PG8_BAR;
    }
    for (;;) {
        const bool has_next = S.next(ui + 1, nxt);
        const char* nA = has_next ? (const char*)g.A + (size_t)nxt.pm * tstep : cA; const char* nB = has_next ? (const char*)g.Bt + (size_t)nxt.pn * tstep : cB;
        for (int t = 0; t < nt; t += 2) {
            const bool last = (t == nt - 2);
            const char* a1 = cA + (size_t)(t + 1) * kstep;
            const char* a2 = last ? nA : cA + (size_t)(t + 2) * kstep; const char* b2 = last ? nB : cB + (size_t)(t + 2) * kstep;
            const char* a3 = a2 + kstep; const char* b3 = b2 + kstep;
            if (last && has_next) S.a_ready(nxt);
            if constexpr (SP2) {
            PG8_LDB(B0, 0, 0); PG8_LDB(B1, 0, 1); PG8_SCHED; PG8_LDA(At, 0, 0); PG8_STAGE(PG8_SA(1, 1), a1 + hstep, voffA);
            PG8_WAIT_V(8); PG8_WAIT_L(0); PG8_BAR; PG8_MMA(0, 0, At, B0); PG8_MMA(0, 1, At, B1); PG8_BAR; PG8_SCHED;
            PG8_LDA(At, 0, 1); PG8_STAGE(PG8_SB(0, 0), b2, voffB); PG8_STAGE(PG8_SB(0, 1), b2 + hstep, voffB); PG8_STAGE(PG8_SA(0, 0), a2, voffA);
            PG8_WAIT_V(8); PG8_WAIT_L(0); PG8_BAR; PG8_MMA(1, 0, At, B0); PG8_MMA(1, 1, At, B1); PG8_BAR; PG8_SCHED;
            PG8_LDB(B0, 1, 0); PG8_LDB(B1, 1, 1); PG8_SCHED; PG8_LDA(At, 1, 0); PG8_STAGE(PG8_SA(0, 1), a2 + hstep, voffA);
            PG8_WAIT_V(8); PG8_WAIT_L(0); PG8_BAR; PG8_MMA(0, 0, At, B0); PG8_MMA(0, 1, At, B1); PG8_BAR; PG8_SCHED;
            PG8_LDA(At, 1, 1); PG8_STAGE(PG8_SB(1, 0), b3, voffB); PG8_STAGE(PG8_SB(1, 1), b3 + hstep, voffB); PG8_STAGE(PG8_SA(1, 0), a3, voffA);
            PG8_WAIT_V(8); PG8_WAIT_L(0); PG8_BAR; PG8_MMA(1, 0, At, B0); PG8_MMA(1, 1, At, B1); PG8_BAR; PG8_SCHED;
            } else {
            PG8_LDB(B0, 0, 0); PG8_SCHED; PG8_LDA(At, 0, 0); PG8_STAGE(PG8_SA(1, 1), a1 + hstep, voffA);
            PG8_WAIT_L(8); PG8_BAR; PG8_WAIT_L(0); PG8_MMA(0, 0, At, B0); PG8_BAR; PG8_SCHED;
            PG8_LDB(B1, 0, 1); PG8_STAGE(PG8_SB(0, 0), b2, voffB);
            PG8_BAR; PG8_WAIT_L(0); PG8_MMA(0, 1, At, B1); PG8_BAR;
            PG8_LDA(At, 0, 1); PG8_STAGE(PG8_SA(0, 0), a2, voffA);
            PG8_BAR; PG8_WAIT_L(0); PG8_MMA(1, 0, At, B0); PG8_BAR; PG8_SCHED;
            PG8_STAGE(PG8_SB(0, 1), b2 + hstep, voffB);
            PG8_WAIT_V(6); PG8_BAR; PG8_MMA(1, 1, At, B1); PG8_BAR;
            PG8_LDB(B0, 1, 0); PG8_SCHED; PG8_LDA(At, 1, 0); PG8_STAGE(PG8_SA(0, 1), a2 + hstep, voffA);
            PG8_WAIT_L(8); PG8_BAR; PG8_WAIT_L(0); PG8_MMA(0, 0, At, B0); PG8_BAR; PG8_SCHED;
            PG8_LDB(B1, 1, 1); PG8_STAGE(PG8_SB(1, 0), b3, voffB);
            PG8_BAR; PG8_WAIT_L(0); PG8_MMA(0, 1, At, B1); PG8_BAR;
            PG8_LDA(At, 1, 1); PG8_STAGE(PG8_SA(1, 0), a3, voffA);
            PG8_BAR; PG8_WAIT_L(0); PG8_MMA(1, 0, At, B0); PG8_BAR; PG8_SCHED;
            PG8_STAGE(PG8_SB(1, 1), b3 + hstep, voffB);
            PG8_WAIT_V(6); PG8_BAR; PG8_MMA(1, 1, At, B1); PG8_BAR;
            }
        }
        if constexpr (ALIGN_EPI) { if (wr == 0) PG8_BAR; }
        if constexpr (!Epi::AFTER_DRAIN) { E(acc, cur, wr, wc, fr, fq); S.done(cur); }
        if (!has_next) break;
#pragma unroll
        for (int a = 0; a < 2; ++a)
#pragma unroll
            for (int b = 0; b < 2; ++b)
#pragma unroll
                for (int m = 0; m < 4; ++m)
#pragma unroll
                    for (int n = 0; n < 2; ++n) acc[a][b][m][n] = (f32x4){0.f, 0.f, 0.f, 0.f};
        cur = nxt; cA = nA; cB = nB; ++ui;
        if constexpr (ALIGN_EPI) { if (wr == 1) PG8_BAR; }
    }
    PG8_WAIT_V(0);
    if constexpr (!ALIGN_EPI) { if (wr == 0) PG8_BAR; }
    PG8_BAR;
    if constexpr (Epi::AFTER_DRAIN) { E.fused(acc, cur, wr, wc, fr, fq, lds, wid, lane); S.done(cur); }
#undef PG8_SA
#undef PG8_SB
#undef PG8_STAGE
#undef PG8_LDA
#undef PG8_LDB
#undef PG8_MMA
#undef PG8_WAIT_V
#undef PG8_WAIT_L
#undef PG8_BAR
#undef PG8_SCHED
}
}
namespace att {
using bf16 = __hip_bfloat16;
using bf16x8 = __attribute__((ext_vector_type(8))) short;
using s16x4  = __attribute__((ext_vector_type(4))) short;
using f32x16 = __attribute__((ext_vector_type(16))) float;
using u32x4  = __attribute__((ext_vector_type(4))) unsigned;
constexpr int SEQ = 4096, QROWS = 128, KVBLK = 64, LDP = 6144, LDC = 2048;
constexpr int SHM_V = KVBLK * 128 * 2, SHM_K = KVBLK * 128 * 2;
constexpr int OFF_WS = 3 * SHM_V + 3 * SHM_K;
constexpr int OFF_STG = 4 * 16384;
constexpr int ATT_LDS = OFF_WS + 8 * 64 * 4;
constexpr float THR = 8.f;
#ifndef ATT_SDEPTH
#define ATT_SDEPTH 1
#endif
constexpr int SDEPTH = ATT_SDEPTH;
#define KSWZ(row, colB) ((row) * 256 + ((colB) ^ (((row) & 15) << 4)))
#define SBAR() __builtin_amdgcn_sched_barrier(0)
__device__ __forceinline__ int crow(int r, int hi) { return (r & 3) + 8 * (r >> 2) + 4 * hi; }
typedef float f32x2_t __attribute__((ext_vector_type(2))); typedef __bf16 bf16x2_t __attribute__((ext_vector_type(2)));
__device__ __forceinline__ unsigned cvtpk(float lo, float hi) { f32x2_t v = {lo, hi}; bf16x2_t b = __builtin_convertvector(v, bf16x2_t); return __builtin_bit_cast(unsigned, b); }
__device__ __forceinline__ void partialSM(f32x16& p0, f32x16& p1, float& m_reg, float& mn, float& alpha) {
  float pmax = p0[0];
#pragma unroll
  for (int r = 1; r < 16; ++r) pmax = fmaxf(pmax, p0[r]);
#pragma unroll
  for (int r = 0; r < 16; ++r) pmax = fmaxf(pmax, p1[r]);
  { auto rr = __builtin_amdgcn_permlane32_swap(__float_as_uint(pmax), __float_as_uint(pmax), false, false);
    pmax = fmaxf(__uint_as_float(rr[0]), __uint_as_float(rr[1])); }
  if (__builtin_expect(__all(pmax - m_reg <= THR), 1)) { mn = m_reg; alpha = 1.f; }
  else { mn = fmaxf(m_reg, pmax); alpha = __builtin_amdgcn_exp2f(m_reg - mn); m_reg = mn; }
#pragma unroll
  for (int r = 0; r < 16; ++r) p0[r] = p0[r] - mn;
#pragma unroll
  for (int r = 0; r < 16; ++r) p1[r] = p1[r] - mn;
#pragma unroll
  for (int r = 0; r < 16; ++r) p0[r] = __builtin_amdgcn_exp2f(p0[r]);
}
__device__ __forceinline__ void finishSM(f32x16& p0, f32x16& p1, float alpha, float& l_reg, bf16x8& pa0, bf16x8& pa1, bf16x8& pa2, bf16x8& pa3) {
#pragma unroll
  for (int r = 0; r < 16; ++r) p1[r] = __builtin_amdgcn_exp2f(p1[r]);
  float ps = 0;
#pragma unroll
  for (int r = 0; r < 16; ++r) ps += p0[r];
#pragma unroll
  for (int r = 0; r < 16; ++r) ps += p1[r];
  { auto rr = __builtin_amdgcn_permlane32_swap(__float_as_uint(ps), __float_as_uint(ps), false, false);
    ps = __uint_as_float(rr[0]) + __uint_as_float(rr[1]); }
  l_reg = l_reg * alpha + ps;
#define PK4(P, BASE, OUT) do { unsigned a0 = cvtpk(P[BASE + 0], P[BASE + 1]), a1 = cvtpk(P[BASE + 2], P[BASE + 3]);   \
    unsigned b0 = cvtpk(P[BASE + 4], P[BASE + 5]), b1 = cvtpk(P[BASE + 6], P[BASE + 7]);                              \
    auto r0 = __builtin_amdgcn_permlane32_swap(a0, b0, false, false); auto r1 = __builtin_amdgcn_permlane32_swap(a1, b1, false, false); \
    u32x4 w = {r0[0], r1[0], r0[1], r1[1]}; OUT = *reinterpret_cast<bf16x8*>(&w); } while (0)
  PK4(p0, 0, pa0); PK4(p0, 8, pa1); PK4(p1, 0, pa2); PK4(p1, 8, pa3);
#undef PK4
}
__device__ __forceinline__ void qkt(f32x16& p0, f32x16& p1, const char* Ks, const bf16x8* qr, int r32, int hi, int cbase) {
  p0 = f32x16{}; p1 = f32x16{};
#pragma unroll
  for (int d0 = 0; d0 < 4; ++d0) { const int cb = cbase + (d0 * 16 + hi * 8) * 2;
    bf16x8 b0 = *reinterpret_cast<const bf16x8*>(Ks + KSWZ(r32, cb));
    bf16x8 b1 = *reinterpret_cast<const bf16x8*>(Ks + KSWZ(32 + r32, cb));
    p0 = __builtin_amdgcn_mfma_f32_32x32x16_bf16(b0, qr[d0], p0, 0, 0, 0);
    p1 = __builtin_amdgcn_mfma_f32_32x32x16_bf16(b1, qr[d0], p1, 0, 0, 0); }
}
__device__ __forceinline__ int v_st(int k, int c) { const int kk = (k & ~0xC) | ((k & 4) << 1) | ((k & 8) >> 1); return ((kk >> 3) * 4 + (c >> 5)) * 512 + ((kk & 7) * 32 + (c & 31)) * 2; }
__device__ __forceinline__ int v_rd_base(int lane) { return ((lane & 3) << 3) | (((lane >> 2) & 3) << 6) | (((lane >> 4) & 1) << 5) | (((lane >> 5) & 1) << 8); }
constexpr int v_rd_off(int d0, int ks, int half) { return d0 * 512 + ks * 4096 + half * 2048; }
typedef short v4i16_t __attribute__((ext_vector_type(4)));
template <int OFF> __device__ __forceinline__ s16x4 tr_read(int vb) {
  return __builtin_bit_cast(s16x4, __builtin_amdgcn_ds_read_tr16_b64_v4i16((__attribute__((address_space(3))) v4i16_t*)(uintptr_t)(unsigned)(vb + OFF)));
}
#define SGB(mask, n) __builtin_amdgcn_sched_group_barrier(mask, n, 0)
__device__ __forceinline__ void pv_d0(f32x16* o, int vb, bf16x8 pa0, bf16x8 pa1, bf16x8 pa2, bf16x8 pa3) {
#define PK(L, H) (bf16x8){L[0], L[1], L[2], L[3], H[0], H[1], H[2], H[3]}
#define KSTEP(KS, PA) do { \
    const s16x4 l0 = tr_read<v_rd_off(0, KS, 0)>(vb), h0 = tr_read<v_rd_off(0, KS, 1)>(vb), l1 = tr_read<v_rd_off(1, KS, 0)>(vb), h1 = tr_read<v_rd_off(1, KS, 1)>(vb); \
    const s16x4 l2 = tr_read<v_rd_off(2, KS, 0)>(vb), h2 = tr_read<v_rd_off(2, KS, 1)>(vb), l3 = tr_read<v_rd_off(3, KS, 0)>(vb), h3 = tr_read<v_rd_off(3, KS, 1)>(vb); \
    o[0] = __builtin_amdgcn_mfma_f32_32x32x16_bf16(PA, PK(l0, h0), o[0], 0, 0, 0); o[1] = __builtin_amdgcn_mfma_f32_32x32x16_bf16(PA, PK(l1, h1), o[1], 0, 0, 0); \
    o[2] = __builtin_amdgcn_mfma_f32_32x32x16_bf16(PA, PK(l2, h2), o[2], 0, 0, 0); o[3] = __builtin_amdgcn_mfma_f32_32x32x16_bf16(PA, PK(l3, h3), o[3], 0, 0, 0); } while (0)
  KSTEP(0, pa0); KSTEP(1, pa1); KSTEP(2, pa2); KSTEP(3, pa3);
#undef KSTEP
#undef PK
}
__device__ __forceinline__ void conv_tile(const bf16* __restrict__ proj, bf16* __restrict__ cat, const float* __restrict__ cw, long row0, int ch0, int lane) {
  const int c8 = ch0 + (lane & 15) * 8; const long r0 = row0 + (lane >> 4) * 8;
  float w0[8], w1[8], w2[8];
#pragma unroll
  for (int e = 0; e < 8; ++e) { w0[e] = cw[c8 + e]; w1[e] = cw[1024 + c8 + e]; w2[e] = cw[2048 + c8 + e]; }
#define LDZ(row, z) do { const bf16x8 c_ = *reinterpret_cast<const bf16x8*>(proj + (long)(row) * LDP + 4096 + c8);     \
    _Pragma("unroll") for (int e = 0; e < 8; ++e) z[e] = __uint_as_float(((unsigned)(unsigned short)c_[e]) << 16); } while (0)
  float zp[8], zc[8], zn[8];
  if ((r0 & (SEQ - 1)) == 0) {
#pragma unroll
    for (int e = 0; e < 8; ++e) zp[e] = 0.f;
  } else LDZ(r0 - 1, zp);
  LDZ(r0, zc);
#pragma unroll
  for (int i = 0; i < 8; ++i) { const long row = r0 + i;
    if (((row + 1) & (SEQ - 1)) == 0) {
#pragma unroll
      for (int e = 0; e < 8; ++e) zn[e] = 0.f;
    } else LDZ(row + 1, zn);
    const bf16x8 gb = *reinterpret_cast<const bf16x8*>(proj + row * LDP + 3072 + c8);
    float y[8];
#pragma unroll
    for (int e = 0; e < 8; ++e) y[e] = __uint_as_float(((unsigned)(unsigned short)gb[e]) << 16) * (zp[e] * w0[e] + zc[e] * w1[e] + zn[e] * w2[e]);
    u32x4 w; w.x = cvtpk(y[0], y[1]); w.y = cvtpk(y[2], y[3]); w.z = cvtpk(y[4], y[5]); w.w = cvtpk(y[6], y[7]);
    *(u32x4*)(cat + row * LDC + 1024 + c8) = w;
#pragma unroll
    for (int e = 0; e < 8; ++e) { zp[e] = zc[e]; zc[e] = zn[e]; }
  }
#undef LDZ
}
__device__ __forceinline__ void glds16(const void* base, unsigned voff, unsigned lds_dst) { unsigned keep;
  asm volatile("s_mov_b32 %0, m0\n\ts_mov_b32 m0, %3\n\ts_nop 0\n\tglobal_load_lds_dwordx4 %1, %2\n\ts_mov_b32 m0, %0" : "=&s"(keep) : "v"(voff), "s"(base), "s"(lds_dst) : "memory"); }
#define WAIT_BAR(N) asm volatile("s_waitcnt vmcnt(" #N ") lgkmcnt(0)\n\ts_barrier" ::: "memory")
__device__ __forceinline__ void attn_unit(const bf16* __restrict__ proj, bf16* __restrict__ cat, int b, int h, int qb, float lam, float oscale, const float* __restrict__ subln, const float* __restrict__ cw, char* lds) {
  int tid_ = threadIdx.x; asm volatile("" : "+v"(tid_));
  const int tid = tid_, wid = __builtin_amdgcn_readfirstlane(tid >> 6), lane = tid & 63, r32 = lane & 31, hi = lane >> 5, rg = wid & 3, mp = wid >> 2;
  char* K_lds = lds; char* V_lds = lds + 3 * SHM_K;
  float* ws = (float*)(lds + OFF_WS) + wid * 64; float* li_l = ws; float* al_l = ws + 32;
  const long rowbase = (long)b * SEQ;
  const bf16* Kh = proj + rowbase * LDP + 1024 + h * 128; const bf16* Vh = proj + rowbase * LDP + 2048 + h * 128;
  float m_reg = -1e30f, l_reg = 0; f32x16 o[4] = {}; bf16x8 qr[4];
  const bf16* Qw = proj + (rowbase + qb * QROWS + rg * 32 + r32) * LDP + (2 * h + mp) * 64 + hi * 8;
#pragma unroll
  for (int d0 = 0; d0 < 4; ++d0) qr[d0] = *reinterpret_cast<const bf16x8*>(Qw + d0 * 16);
  const int cbase = mp * 128;
  unsigned kofs[2], vofs[2];
#pragma unroll
  for (int i = 0; i < 2; ++i) { const int q = wid + 8 * i, p = 64 * q + lane;
    const int krow = p >> 4, kc8 = (p & 15) ^ (krow & 15); kofs[i] = (unsigned)(krow * LDP + kc8 * 8) * 2u;
    const int kk = (p >> 7) * 8 + ((p & 31) >> 2), c = ((p >> 5) & 3) * 32 + (p & 3) * 8, k = (kk & ~0xC) | ((kk & 4) << 1) | ((kk & 8) >> 1); vofs[i] = (unsigned)(k * LDP + c) * 2u; }
  const unsigned lds0 = (unsigned)(uintptr_t)lds, kdst = lds0 + wid * 1024, vdst = lds0 + 3 * SHM_K + wid * 1024;
#define DMA_K(t, slot) do { const bf16* kb_ = Kh + (long)(t) * KVBLK * LDP; glds16(kb_, kofs[0], kdst + (slot) * SHM_K); glds16(kb_, kofs[1], kdst + (slot) * SHM_K + 8192); } while (0)
#define DMA_V(t, slot) do { const bf16* vb_ = Vh + (long)(t) * KVBLK * LDP; glds16(vb_, vofs[0], vdst + (slot) * SHM_V); glds16(vb_, vofs[1], vdst + (slot) * SHM_V + 8192); } while (0)
  const int vb0 = (int)(lds0 + 3 * SHM_K) + v_rd_base(lane);
#define RESC(a) do { if (__any((a) < 1.f)) { if (hi == 0) al_l[r32] = (a); asm volatile("s_waitcnt lgkmcnt(0)" ::: "memory"); \
    _Pragma("unroll") for (int d = 0; d < 4; ++d) _Pragma("unroll") for (int r = 0; r < 16; ++r) o[d][r] *= al_l[crow(r, hi)]; } } while (0)
  f32x16 pA0, pA1, pB0, pB1; float mnA, mnB, alA, alB; bf16x8 pa0, pa1, pa2, pa3; constexpr int NT = SEQ / KVBLK;
  asm volatile("s_waitcnt vmcnt(0)" ::: "memory");
  DMA_K(0, 0); DMA_V(0, 0); DMA_K(1, 1);
  WAIT_BAR(2);
  qkt(pA0, pA1, K_lds, qr, r32, hi, cbase); partialSM(pA0, pA1, m_reg, mnA, alA);
#pragma unroll
  for (int r = 0; r < 16; ++r) pA1[r] = __builtin_amdgcn_exp2f(pA1[r]);
  DMA_V(1, 1); DMA_K(2, 2);
  WAIT_BAR(4);
  int sj = 1;
#define PIN(x) asm volatile("" : "+v"(x))
#define MX3(a, b, c) __builtin_fmaxf(__builtin_fmaxf((a), (b)), (c))
#define PK4(P, BASE, OUT) do { const unsigned a0_ = cvtpk(P[BASE + 0], P[BASE + 1]), a1_ = cvtpk(P[BASE + 2], P[BASE + 3]), b0_ = cvtpk(P[BASE + 4], P[BASE + 5]), b1_ = cvtpk(P[BASE + 6], P[BASE + 7]); \
    auto r0_ = __builtin_amdgcn_permlane32_swap(a0_, b0_, false, false); auto r1_ = __builtin_amdgcn_permlane32_swap(a1_, b1_, false, false); \
    u32x4 w_ = {r0_[0], r1_[0], r0_[1], r1_[1]}; OUT = __builtin_bit_cast(bf16x8, w_); } while (0)
#define PKV(L, H) (bf16x8){L[0], L[1], L[2], L[3], H[0], H[1], H[2], H[3]}
#define RDV(KS, L, H) do { _Pragma("unroll") for (int d_ = 0; d_ < 4; ++d_) { \
    L[d_] = __builtin_bit_cast(s16x4, __builtin_amdgcn_ds_read_tr16_b64_v4i16((__attribute__((address_space(3))) v4i16_t*)(uintptr_t)(unsigned)(vb_ + d_ * 512 + (KS) * 4096))); \
    H[d_] = __builtin_bit_cast(s16x4, __builtin_amdgcn_ds_read_tr16_b64_v4i16((__attribute__((address_space(3))) v4i16_t*)(uintptr_t)(unsigned)(vb_ + d_ * 512 + (KS) * 4096 + 2048))); } } while (0)
#define PVM(D, PA, L, H) o[D] = __builtin_amdgcn_mfma_f32_32x32x16_bf16(PA, PKV(L[D], H[D]), o[D], 0, 0, 0)
#define STEP(PC0, PC1, PP0, PP1, alC, alP, j) do { \
    const int s2_ = (sj == 0) ? 2 : sj - 1, s1_ = (sj == 2) ? 0 : sj + 1; \
    if ((j) + 2 < NT) DMA_K((j) + 2, s2_); if ((j) + 1 < NT) DMA_V((j) + 1, s1_); \
    SBAR(); \
    { const char* Ks_ = K_lds + sj * SHM_K; bf16x8 kf[8]; \
      _Pragma("unroll") for (int d0 = 0; d0 < 4; ++d0) { const int cb = cbase + (d0 * 16 + hi * 8) * 2; \
        kf[2 * d0] = *reinterpret_cast<const bf16x8*>(Ks_ + KSWZ(r32, cb)); kf[2 * d0 + 1] = *reinterpret_cast<const bf16x8*>(Ks_ + KSWZ(32 + r32, cb)); } \
      SBAR(); float ps = 0.f; \
      PC0 = __builtin_amdgcn_mfma_f32_32x32x16_bf16(kf[0], qr[0], f32x16{}, 0, 0, 0); _Pragma("unroll") for (int r = 0; r < 8; ++r) ps += PP0[r]; PIN(ps); SBAR(); \
      PC1 = __builtin_amdgcn_mfma_f32_32x32x16_bf16(kf[1], qr[0], f32x16{}, 0, 0, 0); _Pragma("unroll") for (int r = 8; r < 16; ++r) ps += PP0[r]; PIN(ps); SBAR(); \
      PC0 = __builtin_amdgcn_mfma_f32_32x32x16_bf16(kf[2], qr[1], PC0, 0, 0, 0); _Pragma("unroll") for (int r = 0; r < 8; ++r) ps += PP1[r]; PIN(ps); SBAR(); \
      PC1 = __builtin_amdgcn_mfma_f32_32x32x16_bf16(kf[3], qr[1], PC1, 0, 0, 0); _Pragma("unroll") for (int r = 8; r < 16; ++r) ps += PP1[r]; PIN(ps); SBAR(); \
      PC0 = __builtin_amdgcn_mfma_f32_32x32x16_bf16(kf[4], qr[2], PC0, 0, 0, 0); \
      { auto rr = __builtin_amdgcn_permlane32_swap(__float_as_uint(ps), __float_as_uint(ps), false, false); ps = __uint_as_float(rr[0]) + __uint_as_float(rr[1]); } \
      l_reg = l_reg * alP + ps; PK4(PP0, 0, pa0); PIN(l_reg); PIN(pa0); SBAR(); \
      PC1 = __builtin_amdgcn_mfma_f32_32x32x16_bf16(kf[5], qr[2], PC1, 0, 0, 0); PK4(PP0, 8, pa1); PIN(pa1); SBAR(); \
      PC0 = __builtin_amdgcn_mfma_f32_32x32x16_bf16(kf[6], qr[3], PC0, 0, 0, 0); PK4(PP1, 0, pa2); PIN(pa2); SBAR(); \
      PC1 = __builtin_amdgcn_mfma_f32_32x32x16_bf16(kf[7], qr[3], PC1, 0, 0, 0); PK4(PP1, 8, pa3); PIN(pa3); SBAR(); } \
    { const int vb_ = vb0 + s2_ * SHM_V; s16x4 La[4], Ha[4], Lb[4], Hb[4], Lc[4], Hc[4]; float pm, mn_; \
      RDV(0, La, Ha); RDV(1, Lb, Hb); RDV(2, Lc, Hc); SBAR(); \
      PVM(0, pa0, La, Ha); pm = MX3(PC0[0], PC0[1], PC0[2]); pm = MX3(pm, PC0[3], PC0[4]); pm = MX3(pm, PC0[5], PC0[6]); pm = MX3(pm, PC0[7], PC0[8]); PIN(pm); SBAR(); \
      PVM(1, pa0, La, Ha); pm = MX3(pm, PC0[9], PC0[10]); pm = MX3(pm, PC0[11], PC0[12]); pm = MX3(pm, PC0[13], PC0[14]); pm = MX3(pm, PC0[15], PC1[0]); PIN(pm); SBAR(); \
      PVM(2, pa0, La, Ha); pm = MX3(pm, PC1[1], PC1[2]); pm = MX3(pm, PC1[3], PC1[4]); pm = MX3(pm, PC1[5], PC1[6]); pm = MX3(pm, PC1[7], PC1[8]); PIN(pm); SBAR(); \
      PVM(3, pa0, La, Ha); pm = MX3(pm, PC1[9], PC1[10]); pm = MX3(pm, PC1[11], PC1[12]); pm = MX3(pm, PC1[13], PC1[14]); pm = __builtin_fmaxf(pm, PC1[15]); PIN(pm); SBAR(); \
      RDV(3, La, Ha); SBAR(); \
      PVM(0, pa1, Lb, Hb); \
      { auto rr = __builtin_amdgcn_permlane32_swap(__float_as_uint(pm), __float_as_uint(pm), false, false); pm = __builtin_fmaxf(__uint_as_float(rr[0]), __uint_as_float(rr[1])); } \
      { const bool keep_ = __all(pm - m_reg <= THR); mn_ = keep_ ? m_reg : __builtin_fmaxf(m_reg, pm); alC = keep_ ? 1.f : __builtin_amdgcn_exp2f(m_reg - mn_); m_reg = mn_; } PIN(mn_); PIN(alC); SBAR(); \
      PVM(1, pa1, Lb, Hb); _Pragma("unroll") for (int r = 0; r < 8; ++r) PC0[r] -= mn_; PIN(PC0); SBAR(); \
      PVM(2, pa1, Lb, Hb); _Pragma("unroll") for (int r = 8; r < 16; ++r) PC0[r] -= mn_; PIN(PC0); SBAR(); \
      PVM(3, pa1, Lb, Hb); _Pragma("unroll") for (int r = 0; r < 8; ++r) PC1[r] -= mn_; PIN(PC1); SBAR(); \
      PVM(0, pa2, Lc, Hc); _Pragma("unroll") for (int r = 8; r < 16; ++r) PC1[r] -= mn_; PIN(PC1); SBAR(); \
      PVM(1, pa2, Lc, Hc); _Pragma("unroll") for (int r = 0; r < 4; ++r) PC0[r] = __builtin_amdgcn_exp2f(PC0[r]); PIN(PC0); SBAR(); \
      PVM(2, pa2, Lc, Hc); _Pragma("unroll") for (int r = 4; r < 8; ++r) PC0[r] = __builtin_amdgcn_exp2f(PC0[r]); PIN(PC0); SBAR(); \
      PVM(3, pa2, Lc, Hc); _Pragma("unroll") for (int r = 8; r < 12; ++r) PC0[r] = __builtin_amdgcn_exp2f(PC0[r]); PIN(PC0); SBAR(); \
      PVM(0, pa3, La, Ha); _Pragma("unroll") for (int r = 12; r < 16; ++r) PC0[r] = __builtin_amdgcn_exp2f(PC0[r]); PIN(PC0); SBAR(); \
      PVM(1, pa3, La, Ha); _Pragma("unroll") for (int r = 0; r < 5; ++r) PC1[r] = __builtin_amdgcn_exp2f(PC1[r]); PIN(PC1); SBAR(); \
      PVM(2, pa3, La, Ha); _Pragma("unroll") for (int r = 5; r < 10; ++r) PC1[r] = __builtin_amdgcn_exp2f(PC1[r]); PIN(PC1); SBAR(); \
      PVM(3, pa3, La, Ha); _Pragma("unroll") for (int r = 10; r < 16; ++r) PC1[r] = __builtin_amdgcn_exp2f(PC1[r]); PIN(PC1); SBAR(); } \
    RESC(alC); \
    if ((j) + 2 < NT) WAIT_BAR(4); else if ((j) + 1 < NT) WAIT_BAR(2); else WAIT_BAR(0); \
    sj = s1_; } while (0)
  for (int j = 1; j + 1 < NT; j += 2) {
    STEP(pB0, pB1, pA0, pA1, alB, alA, j);
    STEP(pA0, pA1, pB0, pB1, alA, alB, j + 1);
  }
  STEP(pB0, pB1, pA0, pA1, alB, alA, NT - 1);
  { float ps = 0.f;
#pragma unroll
    for (int r = 0; r < 16; ++r) ps += pB0[r];
#pragma unroll
    for (int r = 0; r < 16; ++r) ps += pB1[r];
    { auto rr = __builtin_amdgcn_permlane32_swap(__float_as_uint(ps), __float_as_uint(ps), false, false); ps = __uint_as_float(rr[0]) + __uint_as_float(rr[1]); }
    l_reg = l_reg * alB + ps; PK4(pB0, 0, pa0); PK4(pB0, 8, pa1); PK4(pB1, 0, pa2); PK4(pB1, 8, pa3); }
  SBAR();
  pv_d0(o, vb0 + ((sj == 0) ? 2 : sj - 1) * SHM_V, pa0, pa1, pa2, pa3);
  if (hi == 0) li_l[r32] = l_reg; asm volatile("s_waitcnt lgkmcnt(0)" ::: "memory");
  float rli[16];
#pragma unroll
  for (int r = 0; r < 16; ++r) rli[r] = __builtin_amdgcn_rcpf(li_l[crow(r, hi)]);
  __syncthreads();
  float* X = (float*)(lds + rg * 16384);
  if (mp == 1) {
#pragma unroll
    for (int d0 = 0; d0 < 4; ++d0)
#pragma unroll
      for (int r = 0; r < 16; ++r) X[(d0 * 16 + r) * 64 + lane] = o[d0][r] * rli[r] * lam;
  }
  __syncthreads();
  if (mp == 0) {
    float g[4];
#pragma unroll
    for (int d0 = 0; d0 < 4; ++d0) g[d0] = subln[d0 * 32 + r32] * oscale;
    bf16* stg = (bf16*)(lds + OFF_STG) + rg * (32 * 128);
#pragma unroll
    for (int r = 0; r < 16; ++r) { float s = 0.f;
#pragma unroll
      for (int d0 = 0; d0 < 4; ++d0) { const float v = o[d0][r] * rli[r] - X[(d0 * 16 + r) * 64 + lane]; o[d0][r] = v; s += v * v; }
      s += __shfl_xor(s, 1); s += __shfl_xor(s, 2); s += __shfl_xor(s, 4); s += __shfl_xor(s, 8); s += __shfl_xor(s, 16);
      const float rs = __builtin_amdgcn_rsqf(s * (1.f / 128.f) + 1e-6f); const int orow = crow(r, hi);
#pragma unroll
      for (int d0 = 0; d0 < 4; ++d0) stg[orow * 128 + d0 * 32 + r32] = __float2bfloat16(o[d0][r] * rs * g[d0]); }
    asm volatile("s_waitcnt lgkmcnt(0)" ::: "memory");
    bf16* Ow = cat + (rowbase + qb * QROWS + rg * 32) * LDC + h * 128;
#pragma unroll
    for (int i = 0; i < 8; ++i) { const int row = i * 4 + (lane >> 4), ch = lane & 15; const u32x4 v = *(const u32x4*)(stg + row * 128 + ch * 8); *(u32x4*)(Ow + (long)row * LDC + ch * 8) = v; }
  } else {
    conv_tile(proj, cat, cw, rowbase + qb * QROWS + rg * 32, h * 128, lane);
  }
  asm volatile("s_waitcnt vmcnt(0)" ::: "memory");
  __syncthreads();
#undef DMA_K
#undef DMA_V
#undef RESC
#undef STEP
}
__device__ __forceinline__ void conv_rows(const bf16* __restrict__ proj, bf16* __restrict__ cat, const float* __restrict__ cw, int row0) {
  int tid_ = threadIdx.x; asm volatile("" : "+v"(tid_));
  const int tid = tid_, cg8 = (tid & 127) * 8, rs = tid >> 7, r0 = row0 + rs * 16;
  float w0[8], w1[8], w2[8];
#pragma unroll
  for (int e = 0; e < 8; ++e) { w0[e] = cw[cg8 + e]; w1[e] = cw[1024 + cg8 + e]; w2[e] = cw[2048 + cg8 + e]; }
  auto ldz = [&](int row, float* z) {
    const bf16x8 c = *reinterpret_cast<const bf16x8*>(proj + (long)row * LDP + 4096 + cg8), u = *reinterpret_cast<const bf16x8*>(proj + (long)row * LDP + 5120 + cg8);
#pragma unroll
    for (int e = 0; e < 8; ++e) z[e] = __uint_as_float(((unsigned)(unsigned short)c[e]) << 16) * __uint_as_float(((unsigned)(unsigned short)u[e]) << 16);
  };
  float zp[8], zc[8], zn[8];
  if ((r0 & (SEQ - 1)) == 0) {
#pragma unroll
    for (int e = 0; e < 8; ++e) zp[e] = 0.f;
  } else ldz(r0 - 1, zp);
  ldz(r0, zc);
#pragma unroll 4
  for (int i = 0; i < 16; ++i) { const int row = r0 + i;
    if (((row + 1) & (SEQ - 1)) == 0) {
#pragma unroll
      for (int e = 0; e < 8; ++e) zn[e] = 0.f;
    } else ldz(row + 1, zn);
    const bf16x8 gb = *reinterpret_cast<const bf16x8*>(proj + (long)row * LDP + 3072 + cg8);
    float y[8];
#pragma unroll
    for (int e = 0; e < 8; ++e) y[e] = __uint_as_float(((unsigned)(unsigned short)gb[e]) << 16) * (zp[e] * w0[e] + zc[e] * w1[e] + zn[e] * w2[e]);
    u32x4 w; w.x = cvtpk(y[0], y[1]); w.y = cvtpk(y[2], y[3]); w.z = cvtpk(y[4], y[5]); w.w = cvtpk(y[6], y[7]);
    *(u32x4*)(cat + (long)row * LDC + 1024 + cg8) = w;
#pragma unroll
    for (int e = 0; e < 8; ++e) { zp[e] = zc[e]; zc[e] = zn[e]; }
  }
}
#undef SBAR
}
constexpr int NWAVES = 8;
#ifndef REP_P0
#define REP_P0 1
#endif
#ifndef REP_G1
#define REP_G1 1
#endif
#ifndef REP_AT
#define REP_AT 1
#endif
#ifndef REP_G3
#define REP_G3 1
#endif
#ifndef REP_SYNC
#define REP_SYNC 0
#endif
constexpr int DM = 2048, BATCH = 4, SEQ = 4096, DEPTH = 4, M = BATCH * SEQ, NIN = 6144, DFF = 5632, NGU = 2 * DFF;
constexpr float EPS = 1e-6f;
constexpr size_t MiB = 1u << 20;
constexpr size_t WS_CTL = 0, CTL_ZERO_BYTES = 1 * MiB;
constexpr size_t WS_ROPE = 1 * MiB;
constexpr size_t WS_WIN = 2 * MiB, WS_WOUT = 98 * MiB, WS_WGU = 130 * MiB, WS_WDN = 306 * MiB;
constexpr size_t WS_XN = 394 * MiB, WS_PROJ = 458 * MiB, WS_CAT = 650 * MiB, WS_PART = 714 * MiB, WS_HID = 716 * MiB, WS_END = 892 * MiB;
constexpr int RSTD_OFF = 131072;
constexpr int LDS_BYTES = 147456;
#define LAS __attribute__((address_space(3)))
typedef unsigned short bf16;
typedef unsigned v4u __attribute__((ext_vector_type(4)));
typedef float f32x4 __attribute__((ext_vector_type(4)));
__device__ __forceinline__ unsigned f2bf(float f) { unsigned u = __builtin_bit_cast(unsigned, f); return (u + 0x7fffu + ((u >> 16) & 1u)) >> 16; }
__device__ __forceinline__ unsigned pk2(float lo, float hi) { return f2bf(lo) | (f2bf(hi) << 16); }
__device__ __forceinline__ float wave_sum(float v) {
#pragma unroll
    for (int o = 1; o < 64; o <<= 1) v += __shfl_xor(v, o);
    return v;
}
__device__ __forceinline__ void p0_transpose_item(const float* __restrict__ W, int K, int N, bf16* __restrict__ WT, int dst_row0, int k0, int n0, LAS float* scr, int lane, const float* __restrict__ gk) {
#pragma unroll 8
    for (int i = 0; i < 32; ++i) { const int kk = 2 * i + (lane >> 5); const float gg = gk ? gk[k0 + kk] : 1.f; scr[kk * 33 + (lane & 31)] = W[(size_t)(k0 + kk) * N + n0 + (lane & 31)] * gg; }
    asm volatile("s_waitcnt lgkmcnt(0)" ::: "memory");
    const int c = lane & 7;
#pragma unroll
    for (int j = 0; j < 4; ++j) { const int n = (lane >> 3) + 8 * j; const LAS float* s = scr + (8 * c) * 33 + n;
        v4u o; o.x = pk2(s[0 * 33], s[1 * 33]); o.y = pk2(s[2 * 33], s[3 * 33]); o.z = pk2(s[4 * 33], s[5 * 33]); o.w = pk2(s[6 * 33], s[7 * 33]);
        *(v4u*)(WT + (size_t)(dst_row0 + n) * K + k0 + 8 * c) = o; }
    asm volatile("s_waitcnt lgkmcnt(0)" ::: "memory");
}
#define XB_TMO      128
#define XB_XCNT(j)  (256  + 64 * (j))
#define XB_XSUB(j)  (1280 + 64 * (j))
#define XB_XGEN(j)  (2304 + 64 * (j))
#define XB_TOP      3328
#define XB_TOPGEN   3392
#define XCD_BAR_WORDS 3456
#define XB_SPIN_CAP (1u << 18)

__device__ __forceinline__ unsigned xb_ld(unsigned* p)              { return __hip_atomic_load(p, __ATOMIC_RELAXED, __HIP_MEMORY_SCOPE_AGENT); }
__device__ __forceinline__ unsigned xb_add(unsigned* p, unsigned v) { return __hip_atomic_fetch_add(p, v, __ATOMIC_RELAXED, __HIP_MEMORY_SCOPE_AGENT); }
__device__ __forceinline__ unsigned xb_xcc_id() { return (unsigned)__builtin_amdgcn_s_getreg((3 << 11) | 20) & 0xFu; }
#define XB_SPIN(cond, bar) do { unsigned _sp = 0; while (cond) { __builtin_amdgcn_s_sleep(1); \
    if ((++_sp & 255u) == 0u) { if (xb_ld(&(bar)[XB_TMO])) break; if (_sp > XB_SPIN_CAP) { atomicAdd(&(bar)[XB_TMO], 1u); break; } } } } while (0)

struct XcdBarrier {
    unsigned* bar; unsigned x;
    volatile LAS unsigned* st;
};

__device__ __forceinline__ XcdBarrier xcd_barrier_post(unsigned* bar, volatile LAS unsigned* st) {
    XcdBarrier b; b.bar = bar; b.x = xb_xcc_id(); b.st = st;
    if (threadIdx.x == 0) (void)xb_add(&bar[XB_XCNT(b.x)], 1u);
    return b;
}
__device__ __forceinline__ void xcd_barrier_complete(unsigned* bar, unsigned x, unsigned& nloc, unsigned& nx) {
    const unsigned G = gridDim.x * gridDim.y * gridDim.z;
    unsigned sum, cnt, mine, sp = 0u;
    for (;;) {
        sum = 0u; cnt = 0u; mine = 0u;
#pragma unroll
        for (unsigned j = 0; j < 16; ++j) { const unsigned c = xb_ld(&bar[XB_XCNT(j)]); sum += c; cnt += (c > 0u) ? 1u : 0u; mine = (j == x) ? c : mine; }
        if (sum == G) break;
        __builtin_amdgcn_s_sleep(1);
        if ((++sp & 255u) == 0u) { if (xb_ld(&bar[XB_TMO])) break; if (sp > XB_SPIN_CAP) { atomicAdd(&bar[XB_TMO], 1u); break; } }
    }
    nloc = mine > 0u ? mine : 1u; nx = cnt > 0u ? cnt : 1u;
}

__device__ __forceinline__ void xcd_barrier(const XcdBarrier& b) {
    asm volatile("s_waitcnt vmcnt(0)" ::: "memory");
    __syncthreads();
    if (threadIdx.x == 0) {
        unsigned* bar = b.bar;
        __builtin_amdgcn_s_waitcnt(0);
        unsigned nloc = b.st[0], nx = b.st[1];
        if (nloc == 0u) { xcd_barrier_complete(bar, b.x, nloc, nx); b.st[0] = nloc; b.st[1] = nx; }
        const unsigned old = xb_add(&bar[XB_XSUB(b.x)], 1u);
        const unsigned gen = old / nloc;
        if (old + 1u == (gen + 1u) * nloc) {
            __builtin_amdgcn_fence(__ATOMIC_RELEASE, "agent");
            asm volatile("s_waitcnt vmcnt(0)" ::: "memory");
            const unsigned og = xb_add(&bar[XB_TOP], 1u);
            const unsigned tg = og / nx;
            if (og + 1u == (tg + 1u) * nx) xb_add(&bar[XB_TOPGEN], 1u);
            else XB_SPIN(xb_ld(&bar[XB_TOPGEN]) == tg, bar);
            __builtin_amdgcn_fence(__ATOMIC_ACQUIRE, "agent");
            xb_add(&bar[XB_XGEN(b.x)], 1u);
            asm volatile("s_waitcnt vmcnt(0)" ::: "memory");
        } else {
            XB_SPIN(xb_ld(&bar[XB_XGEN(b.x)]) == gen, bar);
            __builtin_amdgcn_fence(__ATOMIC_ACQUIRE, "agent");
            asm volatile("s_waitcnt vmcnt(0)" ::: "memory");
        }
    }
    __syncthreads();
}

struct Args { const float* in[15]; float* out; unsigned char* ws; float lam_init[4]; int pad[2]; };

__device__ __forceinline__ void norm_rows_bf16(const float* __restrict__ x, const float* __restrict__ g, bf16* __restrict__ xn, int gw, int NGW, int lane) {
    asm volatile("" : "+v"(lane));
    f32x4 gv[8];
#pragma unroll
    for (int j = 0; j < 8; ++j) gv[j] = ((const f32x4*)g)[lane + 64 * j];
    for (int m = gw; m < M; m += NGW) {
        const f32x4* xr = (const f32x4*)(x + (size_t)m * DM) + lane; f32x4 v[8]; float s = 0.f;
#pragma unroll
        for (int j = 0; j < 8; ++j) { v[j] = xr[64 * j]; s += (v[j].x * v[j].x + v[j].y * v[j].y) + (v[j].z * v[j].z + v[j].w * v[j].w); }
        const float rstd = 1.0f / sqrtf(wave_sum(s) * (1.f / DM) + EPS);
        unsigned long long* o8 = (unsigned long long*)(xn + (size_t)m * DM) + lane;
#pragma unroll
        for (int j = 0; j < 8; ++j) o8[64 * j] = (unsigned long long)pk2(v[j].x * rstd * gv[j].x, v[j].y * rstd * gv[j].y) | ((unsigned long long)pk2(v[j].z * rstd * gv[j].z, v[j].w * rstd * gv[j].w) << 32);
    }
}
__device__ __forceinline__ void norm_rows_f32(float* x, const float* __restrict__ g, int gw, int NGW, int lane) {
    asm volatile("" : "+v"(lane));
    f32x4 gv[8];
#pragma unroll
    for (int j = 0; j < 8; ++j) gv[j] = ((const f32x4*)g)[lane + 64 * j];
    for (int m = gw; m < M; m += NGW) {
        f32x4* xr = (f32x4*)(x + (size_t)m * DM) + lane; f32x4 v[8]; float s = 0.f;
#pragma unroll
        for (int j = 0; j < 8; ++j) { v[j] = xr[64 * j]; s += (v[j].x * v[j].x + v[j].y * v[j].y) + (v[j].z * v[j].z + v[j].w * v[j].w); }
        const float rstd = 1.0f / sqrtf(wave_sum(s) * (1.f / DM) + EPS);
#pragma unroll
        for (int j = 0; j < 8; ++j) xr[64 * j] = v[j] * rstd * gv[j];
    }
}

__device__ __forceinline__ void rstd_finalize(const float* __restrict__ part, int pm, int np, LAS float* rstd_l) {
    int t = threadIdx.x; asm volatile("" : "+v"(t));
    const int row = t >> 1, half = t & 1, pa = half ? (np + 1) / 2 : 0, pb = half ? np : (np + 1) / 2;
    const float* p = part + (size_t)pm * 32 * 256 + row; float s = 0.f;
    for (int i = pa; i < pb; ++i) s += p[i * 256];
    s += __shfl_xor(s, 1);
    if (half == 0) rstd_l[row] = 1.0f / sqrtf(s * (1.f / DM) + EPS);
    __syncthreads();
}
__device__ __forceinline__ void panel_barrier(unsigned* cnt, unsigned target, bool full) {
    asm volatile("s_waitcnt vmcnt(0)" ::: "memory");
    __syncthreads();
    if (threadIdx.x == 0) {
        if (full) { __builtin_amdgcn_fence(__ATOMIC_RELEASE, "agent"); asm volatile("s_waitcnt vmcnt(0)" ::: "memory"); }
        (void)__hip_atomic_fetch_add(cnt, 1u, __ATOMIC_RELAXED, __HIP_MEMORY_SCOPE_AGENT);
        unsigned sp = 0;
        while (__hip_atomic_load(cnt, __ATOMIC_RELAXED, __HIP_MEMORY_SCOPE_AGENT) < target) { __builtin_amdgcn_s_sleep(1); if (++sp > (1u << 22)) break; }
        __builtin_amdgcn_fence(__ATOMIC_ACQUIRE, "agent");
        asm volatile("s_waitcnt vmcnt(0)" ::: "memory");
    }
    __syncthreads();
}
__global__ void __launch_bounds__(NWAVES * 64, 2) fwd_megakernel(Args args) {
    extern __shared__ __attribute__((aligned(16))) unsigned char lds[];
    cg::grid_group grid = cg::this_grid();
#define GRID_SYNC() do { asm volatile("s_waitcnt vmcnt(0)" ::: "memory"); grid.sync(); } while (0)
    const int tid = threadIdx.x, lane = tid & 63, wave = __builtin_amdgcn_readfirstlane(tid >> 6);
    const int G = gridDim.x, bx = blockIdx.x, vcu = (G % 8 == 0) ? (bx % 8) * (G / 8) + bx / 8 : bx;
    const int gw = vcu * NWAVES + wave, NGW = G * NWAVES;
    unsigned char* ws = args.ws;
    LAS unsigned char* ldsl_ = (LAS unsigned char*)lds;
    const float* x_in = args.in[0]; const float* norm_mix = args.in[1]; const float* w_in = args.in[2];
    const float* lq1 = args.in[3]; const float* lk1 = args.in[4]; const float* lq2 = args.in[5]; const float* lk2 = args.in[6];
    const float* subln = args.in[7]; const float* conv_w = args.in[8]; const float* w_out = args.in[9]; const float* norm_ffn = args.in[10];
    const float* w_gate = args.in[11]; const float* w_up = args.in[12]; const float* w_down = args.in[13]; const float* norm_final = args.in[14];
    float* out = args.out;
    float* PART = (float*)(ws + WS_PART);
    LAS float* rstd_l = (LAS float*)(ldsl_ + RSTD_OFF);
    const int pm0 = 8 * (bx & 7) + ((bx >> 3) & 7);
    float* cosT = (float*)(ws + WS_ROPE); float* sinT = cosT + 4096 * 32;
    bf16* Win_t = (bf16*)(ws + WS_WIN); bf16* Wout_t = (bf16*)(ws + WS_WOUT); bf16* Wgu_t = (bf16*)(ws + WS_WGU); bf16* Wdn_t = (bf16*)(ws + WS_WDN);
    bf16* XN = (bf16*)(ws + WS_XN); bf16* PROJ = (bf16*)(ws + WS_PROJ); bf16* CAT = (bf16*)(ws + WS_CAT); bf16* HID = (bf16*)(ws + WS_HID);
    LAS unsigned char* ldsl = ldsl_;

    volatile LAS unsigned* MISC = (volatile LAS unsigned*)(ldsl_ + RSTD_OFF + 1024);
    if (tid < 32) MISC[tid] = 0u;
    __syncthreads();
    XcdBarrier xbar = xcd_barrier_post((unsigned*)(ws + WS_CTL) + 4096, MISC + 8);
#define XCD_SYNC() xcd_barrier(xbar)
    unsigned* pcnt = (unsigned*)(ws + WS_CTL) + 16384 + 64 * pm0; unsigned pb_target = 0u; bool pb_full = true;
    if (tid == 0) (void)__hip_atomic_fetch_or(pcnt + 1, 1u << xbar.x, __ATOMIC_RELAXED, __HIP_MEMORY_SCOPE_AGENT);
#define PANEL_SYNC() do { pb_target += 4u; panel_barrier(pcnt, pb_target, pb_full); } while (0)
    unsigned* qcnt = (unsigned*)(ws + WS_CTL) + 28672 + 64 * ((bx & 7) >> 1); unsigned qb_target = 0u;
#define PAIR_SYNC() do { qb_target += 64u; panel_barrier(qcnt, qb_target, true); } while (0)
    for (int rep_ = 0; rep_ < REP_P0; ++rep_) {
        LAS float* scr = (LAS float*)(ldsl + wave * 16384);
        constexpr int I_IN = (DM / 64) * (NIN / 32), I_OUT = (DM / 64) * (DM / 32), I_G = (DM / 64) * (DFF / 32), I_D = (DFF / 64) * (DM / 32);
        constexpr int I_LAYER = I_IN + I_OUT + 2 * I_G + I_D, NITEMS = DEPTH * I_LAYER;
        struct P0Item { const float* src; const float* gk; bf16* dst; int N, K; };
        auto decode = [&](int it, P0Item& I) {
            const int l = it / I_LAYER; int r = it % I_LAYER; const float* W; const float* g = nullptr; bf16* WT; int N, K, d0, kb, c0;
            if (r < I_IN) { N = NIN; K = DM; const int nblk = NIN / 32; kb = r / nblk; c0 = (r % nblk) * 32; d0 = c0;
                if (c0 < 2048) d0 = (c0 & ~255) + 128 * ((c0 >> 5) & 1) + 32 * ((c0 >> 6) & 3);
                else if (c0 >= 4096) { const int isu = c0 >= 5120, c = c0 - 4096 - 1024 * isu; d0 = 4096 + (c >> 7) * 256 + 128 * isu + (c & 127); }
                W = w_in + (size_t)l * DM * NIN; WT = Win_t + (size_t)l * NIN * DM; g = norm_mix + l * DM; }
            else if ((r -= I_IN) < I_OUT) { N = DM; K = DM; const int nblk = DM / 32; kb = r / nblk; c0 = (r % nblk) * 32; d0 = c0;
                W = w_out + (size_t)l * DM * DM; WT = Wout_t + (size_t)l * DM * DM; }
            else if ((r -= I_OUT) < 2 * I_G) { const int up = r >= I_G; if (up) r -= I_G; N = DFF; K = DM; const int nblk = DFF / 32; kb = r / nblk; c0 = (r % nblk) * 32;
                d0 = (c0 >> 7) * 256 + up * 128 + (c0 & 127);
                W = (up ? w_up : w_gate) + (size_t)l * DM * DFF; WT = Wgu_t + (size_t)l * NGU * DM; g = norm_ffn + l * DM; }
            else { r -= 2 * I_G; N = DM; K = DFF; const int nblk = DM / 32; kb = r / nblk; c0 = (r % nblk) * 32; d0 = c0;
                W = w_down + (size_t)l * DFF * DM; WT = Wdn_t + (size_t)l * DM * DFF; }
            const int k0 = kb * 64;
            I.src = W + (size_t)(k0 + (lane >> 3)) * N + c0 + (lane & 7) * 4;
            I.gk = g ? g + k0 + 8 * (lane & 7) : nullptr;
            I.dst = WT + (size_t)(d0 + (lane >> 3)) * K + k0 + 8 * (lane & 7);
            I.N = N; I.K = K;
        };
        P0Item A, B; f32x4 cur[8], nxt[8];
        if (gw < NITEMS) { decode(gw, A);
#pragma unroll
            for (int i = 0; i < 8; ++i) cur[i] = __builtin_nontemporal_load((const f32x4*)(A.src + (size_t)i * 8 * A.N)); }
        for (int it = gw; it < NITEMS; it += NGW) {
            const bool hasB = it + NGW < NITEMS;
            if (hasB) { decode(it + NGW, B);
#pragma unroll
                for (int i = 0; i < 8; ++i) nxt[i] = __builtin_nontemporal_load((const f32x4*)(B.src + (size_t)i * 8 * B.N)); }
#pragma unroll
            for (int i = 0; i < 8; ++i) { LAS float* w = scr + (8 * i + (lane >> 3)) * 33 + (lane & 7) * 4; w[0] = cur[i].x; w[1] = cur[i].y; w[2] = cur[i].z; w[3] = cur[i].w; }
            asm volatile("s_waitcnt lgkmcnt(0)" ::: "memory");
            f32x4 g0 = {1.f, 1.f, 1.f, 1.f}, g1 = g0;
            if (A.gk) { g0 = *(const f32x4*)A.gk; g1 = *(const f32x4*)(A.gk + 4); }
#pragma unroll
            for (int j = 0; j < 4; ++j) { const LAS float* sp = scr + (8 * (lane & 7)) * 33 + (lane >> 3) + 8 * j;
                v4u o; o.x = pk2(sp[0 * 33] * g0.x, sp[1 * 33] * g0.y); o.y = pk2(sp[2 * 33] * g0.z, sp[3 * 33] * g0.w); o.z = pk2(sp[4 * 33] * g1.x, sp[5 * 33] * g1.y); o.w = pk2(sp[6 * 33] * g1.z, sp[7 * 33] * g1.w);
                *(v4u*)(A.dst + (size_t)j * 8 * A.K) = o; }
            asm volatile("s_waitcnt lgkmcnt(0)" ::: "memory");
            if (hasB) { A = B;
#pragma unroll
                for (int i = 0; i < 8; ++i) cur[i] = nxt[i]; }
        }
        for (int i = bx * (NWAVES * 64) + tid; i < 4096 * 32; i += G * NWAVES * 64) {
            const int pos = i >> 5, j = i & 31;
            const float inv_freq = (float)exp2(-(double)j * (13.287712379549449 / 32.0));
            const float ang = (float)pos * inv_freq;
            const double t = (double)ang, kq = rint(t * 0.63661977236758134), y = t - kq * 1.5707963267948966, y2 = y * y;
            const double sn = y * (1.0 + y2 * (-1.0 / 6 + y2 * (1.0 / 120 + y2 * (-1.0 / 5040 + y2 * (1.0 / 362880 + y2 * (-1.0 / 39916800 + y2 * (1.0 / 6227020800.0 + y2 * (-1.0 / 1307674368000.0))))))));
            const double cs = 1.0 + y2 * (-0.5 + y2 * (1.0 / 24 + y2 * (-1.0 / 720 + y2 * (1.0 / 40320 + y2 * (-1.0 / 3628800 + y2 * (1.0 / 479001600.0 + y2 * (-1.0 / 87178291200.0 + y2 * (1.0 / 20922789888000.0))))))));
            const int q = (int)((long long)kq & 3);
            const double sv = (q == 0) ? sn : (q == 1) ? cs : (q == 2) ? -sn : -cs, cv = (q == 0) ? cs : (q == 1) ? -sn : (q == 2) ? -cs : sn;
            cosT[i] = (float)cv; sinT[i] = (float)sv;
        }
    }
    {
        for (int m = gw; m < M; m += NGW) {
            const f32x4* xr = (const f32x4*)(x_in + (size_t)m * DM) + lane; f32x4 v[8]; float sq = 0.f;
#pragma unroll
            for (int j = 0; j < 8; ++j) { v[j] = __builtin_nontemporal_load(xr + 64 * j); sq += (v[j].x * v[j].x + v[j].y * v[j].y) + (v[j].z * v[j].z + v[j].w * v[j].w); }
            sq = wave_sum(sq); if (lane == 0) PART[((size_t)(m >> 8) * 32) * 256 + (m & 255)] = sq;
            unsigned long long* o8 = (unsigned long long*)(XN + (size_t)m * DM) + lane;
#pragma unroll
            for (int j = 0; j < 8; ++j) o8[64 * j] = (unsigned long long)pk2(v[j].x, v[j].y) | ((unsigned long long)pk2(v[j].z, v[j].w) << 32);
        }
    }
    GRID_SYNC();
    pb_full = __builtin_popcount(__builtin_amdgcn_readfirstlane((int)__hip_atomic_load(pcnt + 1, __ATOMIC_RELAXED, __HIP_MEMORY_SCOPE_AGENT))) != 1;

#pragma unroll 1
    for (int l = 0; l < DEPTH; ++l) {
#ifndef NO_G1
        rstd_finalize(PART, pm0, l == 0 ? 1 : 32, rstd_l);
        for (int rep_ = 0; rep_ < REP_G1; ++rep_) { pg8::Gemm g{XN, Win_t + (size_t)l * NIN * DM, M, NIN, DM}; pg8::StaticOrder S; S.init(M, NIN, G, bx);
          pg8::EpiInProj E{PROJ, NIN, cosT, sinT, rstd_l};
          pg8::gemm_phase<pg8::EpiInProj, pg8::StaticOrder, true, true>(ldsl, g, S, E); }
#endif
        PAIR_SYNC();
        {
            float lam;
            { const float a = wave_sum(lq1[l * 64 + lane] * lk1[l * 64 + lane]), b2 = wave_sum(lq2[l * 64 + lane] * lk2[l * 64 + lane]);
              lam = expf(a) - expf(b2) + args.lam_init[l]; }
            const float oscale = 1.0f - args.lam_init[l];
            const int xcd = vcu >> 5, jq = vcu & 31;
#ifndef NO_AT
            for (int rep_ = 0; rep_ < REP_AT; ++rep_)
            for (int i = 0; ; ++i) { int bh, qb;
                if (G == 256) { if (i >= 4) break; bh = xcd * 4 + i; qb = jq; } else { const int u = bx + i * G; if (u >= 1024) break; bh = u >> 5; qb = u & 31; }
                att::attn_unit((const att::bf16*)PROJ, (att::bf16*)CAT, bh >> 3, bh & 7, qb, lam, oscale, subln + l * 128, conv_w + l * 3 * 1024, (char*)lds); }
#endif
        }
        PAIR_SYNC();
#ifndef NO_G2
        { pg8::Gemm g{CAT, Wout_t + (size_t)l * DM * DM, M, DM, DM}; pg8::StaticOrder S; S.init(M, DM, G, bx);
          pg8::EpiResid E{XN, DM, PART};
          pg8::gemm_phase<pg8::EpiResid, pg8::StaticOrder, true, true>(ldsl, g, S, E); }
#endif
        PANEL_SYNC();
#ifndef NO_G3
        rstd_finalize(PART, pm0, 32, rstd_l);
        for (int rep_ = 0; rep_ < REP_G3; ++rep_) { pg8::Gemm g{XN, Wgu_t + (size_t)l * NGU * DM, M, NGU, DM}; pg8::StaticOrder S; S.init(M, NGU, G, bx);
          pg8::EpiSwiGLU E{HID, DFF, rstd_l};
          pg8::gemm_phase<pg8::EpiSwiGLU, pg8::StaticOrder, true, true>(ldsl, g, S, E); }
#endif
        PANEL_SYNC();
#ifndef NO_G4
        { pg8::Gemm g{HID, Wdn_t + (size_t)l * DM * DFF, M, DM, DFF}; pg8::StaticOrder S; S.init(M, DM, G, bx);
          pg8::EpiResid E{XN, DM, PART};
          pg8::gemm_phase<pg8::EpiResid, pg8::StaticOrder, true, true>(ldsl, g, S, E); }
#endif
        PANEL_SYNC();
        for (int rep_ = 0; rep_ < REP_SYNC; ++rep_) XCD_SYNC();
    }
    {
        int lane_ = threadIdx.x & 63; asm volatile("" : "+v"(lane_)); const int lane = lane_;
        f32x4 gv[8];
#pragma unroll
        for (int j = 0; j < 8; ++j) gv[j] = ((const f32x4*)norm_final)[lane + 64 * j];
        for (int k_ = 0; k_ < 8; ++k_) { const int m = pm0 * 256 + (bx >> 6) * 64 + wave * 8 + k_;
            float sq = (lane < 32) ? PART[((size_t)(m >> 8) * 32 + lane) * 256 + (m & 255)] : 0.f;
            sq = wave_sum(sq);
            const float rstd = 1.0f / sqrtf(sq * (1.f / DM) + EPS);
            const unsigned long long* xr = (const unsigned long long*)(XN + (size_t)m * DM) + lane;
            f32x4* orow = (f32x4*)(out + (size_t)m * DM) + lane;
#pragma unroll
            for (int j = 0; j < 8; ++j) { const unsigned long long w = xr[64 * j]; const unsigned lo = (unsigned)w, hi = (unsigned)(w >> 32);
                f32x4 v = {__uint_as_float(lo << 16), __uint_as_float(lo & 0xffff0000u), __uint_as_float(hi << 16), __uint_as_float(hi & 0xffff0000u)};
                __builtin_nontemporal_store(v * rstd * gv[j], orow + 64 * j); }
        }
    }
}

extern "C" void kernel_launch(void* const* d_in, const int* in_sizes, int n_in, void* d_out, int out_size, void* d_ws, size_t ws_size, hipStream_t stream) {
    static int grid = 0;
    if (grid == 0) {
        if (n_in != 15 || in_sizes[0] != M * DM || out_size != M * DM || ws_size < WS_END) {
            fprintf(stderr, "kernel_launch: unexpected shapes: n_in %d in0 %d out %d ws %zu (need >= %zu)\n", n_in, n_in > 0 ? in_sizes[0] : -1, out_size, ws_size, (size_t)WS_END); grid = -1; return; }
        int dev = 0, cus = 0, per_cu = 0;
        if (hipGetDevice(&dev) != hipSuccess || hipDeviceGetAttribute(&cus, hipDeviceAttributeMultiprocessorCount, dev) != hipSuccess) { grid = -1; return; }
        if (hipFuncSetAttribute((const void*)fwd_megakernel, hipFuncAttributeMaxDynamicSharedMemorySize, LDS_BYTES) != hipSuccess) { fprintf(stderr, "kernel_launch: hipFuncSetAttribute failed\n"); grid = -1; return; }
        if (hipOccupancyMaxActiveBlocksPerMultiprocessor(&per_cu, (const void*)fwd_megakernel, NWAVES * 64, LDS_BYTES) != hipSuccess || per_cu < 1) { fprintf(stderr, "kernel_launch: occupancy query says %d\n", per_cu); per_cu = 1; }
        (void)hipGetLastError();
        grid = cus * 1;
    }
    if (grid < 0) return;
    Args a{};
    for (int i = 0; i < 15; ++i) a.in[i] = (const float*)d_in[i];
    a.out = (float*)d_out; a.ws = (unsigned char*)d_ws;
    for (int l = 0; l < 4; ++l) a.lam_init[l] = (float)(0.8 - 0.6 * std::exp(-0.3 * (double)l));
    if (hipMemsetAsync((char*)d_ws + WS_CTL, 0, CTL_ZERO_BYTES, stream) != hipSuccess) { fprintf(stderr, "kernel_launch: memset failed\n"); return; }
    void* kargs[] = {&a};
    hipError_t e = hipLaunchCooperativeKernel((const void*)fwd_megakernel, dim3(grid), dim3(NWAVES * 64), kargs, LDS_BYTES, stream);
    if (e != hipSuccess) fprintf(stderr, "kernel_launch: cooperative launch failed: %s (grid %d)\n", hipGetErrorString(e), grid);
}
```

```cpp
#include <hip/hip_runtime.h>
#include <hip/hip_cooperative_groups.h>
#include <hip/hip_bf16.h>
#include <cstdio>
#include <cstdint>
#include <cmath>
namespace cg = cooperative_groups;
namespace pg8 {
#define PG8_LAS __attribute__((address_space(3)))
typedef unsigned short bf16_t;
typedef short bf16x8 __attribute__((ext_vector_type(8)));
typedef float f32x4 __attribute__((ext_vector_type(4)));
typedef unsigned u32x4 __attribute__((ext_vector_type(4)));
constexpr int BM = 256, BK = 64, HALF = 128, HTB = HALF * BK * 2  , STAGE_BYTES = 8 * HTB, NXCD = 8, WGM = 8;

__host__ __device__ __forceinline__ int lds_byte(int r, int c) { const int st = (r >> 4) * 2 + (c >> 5), rr = r & 15, cc = c & 31, ob = rr * 64 + cc * 2; return st * 1024 + (ob ^ (((ob >> 9) & 1) << 5)); }
__host__ __device__ __forceinline__ void stage_rc(int b, int& R, int& C) { const int st = b / 1024, sb = b % 1024, swz = sb ^ (((sb >> 9) & 1) << 5); R = (st >> 1) * 16 + swz / 64; C = (st & 1) * 32 + (swz % 64) / 2; }
__host__ __device__ __forceinline__ int perm32(int rho) { const int n = rho >> 4, i = rho & 15; return 8 * (i >> 2) + 4 * n + (i & 3); }

struct Unit { int pm, pn; };
struct Gemm { const bf16_t* A; const bf16_t* Bt; int M, N, K; };

struct StaticOrder {
    int nM, nN, nwg, G, c;
    __host__ __device__ void init(int M, int N, int G_, int c_) { nM = M / BM; nN = N / BM; nwg = nM * nN; G = G_; c = c_; }
    __host__ __device__ bool next(int i, Unit& u) const {
        const long L = (long)i * G + c; if (L >= nwg) return false;
        int wgid = (int)L; { const int q = nwg / NXCD, r = nwg % NXCD, xcd = wgid % NXCD, off = wgid / NXCD; wgid = (xcd < r ? xcd * (q + 1) : r * (q + 1) + (xcd - r) * q) + off; }
        const int nig = WGM * nN, gid = wgid / nig, fm = gid * WGM, gsz = (nM - fm) < WGM ? (nM - fm) : WGM;
        u.pm = fm + ((wgid % nig) % gsz); u.pn = (wgid % nig) / gsz; return true;
    }
    __device__ __forceinline__ void a_ready(const Unit&) const {}
    __device__ __forceinline__ void done(const Unit&) const {}
};

__device__ __forceinline__ unsigned cvt_pk_bf16(float lo, float hi) { unsigned r; asm volatile("v_cvt_pk_bf16_f32 %0, %1, %2" : "=v"(r) : "v"(lo), "v"(hi)); return r; }
typedef float f32x2 __attribute__((ext_vector_type(2)));
typedef unsigned u32x2 __attribute__((ext_vector_type(2)));
constexpr float QSCALE = 0.125f * 1.4426950408889634f;

struct EpiInProj {
    static constexpr bool PERM = true, AFTER_DRAIN = false;
    bf16_t* O; int ldc; const float* cosT; const float* sinT; const PG8_LAS float* rstd;
    __device__ __forceinline__ void operator()(const f32x4 (&acc)[2][2][4][2], const Unit& u, int wr, int wc, int fr, int fq) const {
        const int row0 = u.pm * BM + wr * 64 + fr;
        if (u.pn < 8) {
            const float sc = (u.pn < 4) ? QSCALE : 1.f;
            const int col = u.pn * BM + 64 * wc + 8 * fq;
#pragma unroll
            for (int ai = 0; ai < 2; ++ai)
#pragma unroll
                for (int m = 0; m < 4; ++m) { const int row = row0 + ai * HALF + m * 16; const int pos = row & 4095;
                    const float rs = sc * rstd[row & 255];
                    const f32x4 c0 = *(const f32x4*)(cosT + pos * 32 + 8 * fq), c1 = *(const f32x4*)(cosT + pos * 32 + 8 * fq + 4);
                    const f32x4 s0 = *(const f32x4*)(sinT + pos * 32 + 8 * fq), s1 = *(const f32x4*)(sinT + pos * 32 + 8 * fq + 4);
                    const f32x4 a0 = acc[ai][0][m][0], a1 = acc[ai][0][m][1], b0 = acc[ai][1][m][0], b1 = acc[ai][1][m][1];
                    const f32x4 x0 = (a0 * c0 - b0 * s0) * rs, x1 = (a1 * c1 - b1 * s1) * rs, y0 = (b0 * c0 + a0 * s0) * rs, y1 = (b1 * c1 + a1 * s1) * rs;
                    bf16_t* rowp = O + (size_t)row * ldc + col;
                    u32x4 w; w.x = cvt_pk_bf16(x0[0], x0[1]); w.y = cvt_pk_bf16(x0[2], x0[3]); w.z = cvt_pk_bf16(x1[0], x1[1]); w.w = cvt_pk_bf16(x1[2], x1[3]);
                    *(u32x4*)rowp = w;
                    w.x = cvt_pk_bf16(y0[0], y0[1]); w.y = cvt_pk_bf16(y0[2], y0[3]); w.z = cvt_pk_bf16(y1[0], y1[1]); w.w = cvt_pk_bf16(y1[2], y1[3]);
                    *(u32x4*)(rowp + 32) = w; }
        } else if (u.pn >= 16) {
            const int col0 = 4096 + (u.pn - 16) * HALF + wc * 32 + 8 * fq;
#pragma unroll
            for (int ai = 0; ai < 2; ++ai)
#pragma unroll
                for (int m = 0; m < 4; ++m) { const int row = row0 + ai * HALF + m * 16; const float rs = rstd[row & 255], rs2 = rs * rs;
                    const f32x4 z0 = acc[ai][0][m][0] * acc[ai][1][m][0] * rs2, z1 = acc[ai][0][m][1] * acc[ai][1][m][1] * rs2;
                    u32x4 w; w.x = cvt_pk_bf16(z0[0], z0[1]); w.y = cvt_pk_bf16(z0[2], z0[3]); w.z = cvt_pk_bf16(z1[0], z1[1]); w.w = cvt_pk_bf16(z1[2], z1[3]);
                    *(u32x4*)(O + (size_t)row * ldc + col0) = w; }
        } else {
            const int col0 = u.pn * BM + wc * 32 + 8 * fq;
#pragma unroll
            for (int ai = 0; ai < 2; ++ai)
#pragma unroll
                for (int m = 0; m < 4; ++m) { const int row = row0 + ai * HALF + m * 16; bf16_t* rowp = O + (size_t)row * ldc + col0;
                    const float rs = rstd[row & 255];
#pragma unroll
                    for (int bj = 0; bj < 2; ++bj) { const f32x4 v0 = acc[ai][bj][m][0] * rs, v1 = acc[ai][bj][m][1] * rs;
                        u32x4 w; w.x = cvt_pk_bf16(v0[0], v0[1]); w.y = cvt_pk_bf16(v0[2], v0[3]); w.z = cvt_pk_bf16(v1[0], v1[1]); w.w = cvt_pk_bf16(v1[2], v1[3]);
                        *(u32x4*)(rowp + bj * HALF) = w; } }
        }
    }
};
__device__ __forceinline__ float bf_lo(unsigned w) { return __uint_as_float(w << 16); }
__device__ __forceinline__ float bf_hi(unsigned w) { return __uint_as_float(w & 0xffff0000u); }
struct EpiResid {
    static constexpr bool PERM = true, AFTER_DRAIN = false;
    bf16_t* xb; int ldc; float* part;
    __device__ __forceinline__ void operator()(const f32x4 (&acc)[2][2][4][2], const Unit& u, int wr, int wc, int fr, int fq) const {
        const int row0 = u.pm * BM + wr * 64 + fr, col0 = u.pn * BM + wc * 32 + 8 * fq;
#pragma unroll
        for (int ai = 0; ai < 2; ++ai) {
            u32x4 xr[4][2];
#pragma unroll
            for (int m = 0; m < 4; ++m)
#pragma unroll
                for (int bj = 0; bj < 2; ++bj) xr[m][bj] = *(const u32x4*)(xb + (size_t)(row0 + ai * HALF + m * 16) * ldc + col0 + bj * HALF);
            asm volatile("" : "+v"(xr[0][0]), "+v"(xr[0][1]), "+v"(xr[1][0]), "+v"(xr[1][1]), "+v"(xr[2][0]), "+v"(xr[2][1]), "+v"(xr[3][0]), "+v"(xr[3][1]));
#pragma unroll
            for (int m = 0; m < 4; ++m) { const int row = row0 + ai * HALF + m * 16; const size_t off = (size_t)row * ldc + col0; float s = 0.f;
#pragma unroll
                for (int bj = 0; bj < 2; ++bj) { const u32x4 b = xr[m][bj];
                    const f32x4 v0 = (f32x4){bf_lo(b.x), bf_hi(b.x), bf_lo(b.y), bf_hi(b.y)} + acc[ai][bj][m][0], v1 = (f32x4){bf_lo(b.z), bf_hi(b.z), bf_lo(b.w), bf_hi(b.w)} + acc[ai][bj][m][1];
                    u32x4 w; w.x = cvt_pk_bf16(v0[0], v0[1]); w.y = cvt_pk_bf16(v0[2], v0[3]); w.z = cvt_pk_bf16(v1[0], v1[1]); w.w = cvt_pk_bf16(v1[2], v1[3]); *(u32x4*)(xb + off + bj * HALF) = w;
                    s += (v0[0] * v0[0] + v0[1] * v0[1]) + (v0[2] * v0[2] + v0[3] * v0[3]) + (v1[0] * v1[0] + v1[1] * v1[1]) + (v1[2] * v1[2] + v1[3] * v1[3]); }
                s += __shfl_xor(s, 16); s += __shfl_xor(s, 32); if (fq == 0) part[((size_t)u.pm * 32 + u.pn * 4 + wc) * 256 + (row & 255)] = s; }
        }
    }
};
struct EpiSwiGLU {
    static constexpr bool PERM = true, AFTER_DRAIN = false;
    bf16_t* O; int ldc; const PG8_LAS float* rstd;
    __device__ __forceinline__ void operator()(const f32x4 (&acc)[2][2][4][2], const Unit& u, int wr, int wc, int fr, int fq) const {
        const int row0 = u.pm * BM + wr * 64 + fr, col0 = u.pn * HALF + wc * 32 + 8 * fq;
#pragma unroll
        for (int ai = 0; ai < 2; ++ai)
#pragma unroll
            for (int m = 0; m < 4; ++m) { const int row = row0 + ai * HALF + m * 16;
                const float rs = rstd[row & 255];
                float h[8];
#pragma unroll
                for (int n = 0; n < 2; ++n)
#pragma unroll
                    for (int e = 0; e < 4; ++e) { const float g = acc[ai][0][m][n][e] * rs, up = acc[ai][1][m][n][e] * rs;
                        h[n * 4 + e] = g * up * __builtin_amdgcn_rcpf(1.f + __builtin_amdgcn_exp2f(-1.4426950408889634f * g)); }
                u32x4 w; w.x = cvt_pk_bf16(h[0], h[1]); w.y = cvt_pk_bf16(h[2], h[3]); w.z = cvt_pk_bf16(h[4], h[5]); w.w = cvt_pk_bf16(h[6], h[7]);
                *(u32x4*)(O + (size_t)row * ldc + col0) = w; }
    }
};
template <class Epi, class Sched, bool ALIGN_EPI = false, bool SP2 = false>
__device__ __forceinline__ void gemm_phase(PG8_LAS unsigned char* lds, const Gemm g, const Sched& S, const Epi& E) {
    int tid_ = threadIdx.x; asm volatile("" : "+v"(tid_));
    const int tid = tid_, wid = __builtin_amdgcn_readfirstlane(tid >> 6), lane = tid & 63, wr = wid >> 2, wc = wid & 3, fr = lane & 15, fq = lane >> 4;
    const int K = g.K, nt = K / BK;
    unsigned voffA[2], voffB[2];
#pragma unroll
    for (int i = 0; i < 2; ++i) { int R, C; stage_rc(tid * 16 + i * 8192, R, C); const int Rb = Epi::PERM ? ((R & ~31) + perm32(R & 31)) : R;
        voffA[i] = (unsigned)(R * K + C) * 2u; voffB[i] = (unsigned)(Rb * K + C) * 2u; }
    const size_t kstep = (size_t)(BK * 2);
    const size_t hstep = (size_t)HALF * K * 2;
    const size_t tstep = 2 * hstep;
    const unsigned ldsw = (unsigned)wid * 1024u;
    const int aoff = lds_byte(wr * 64 + fr, fq * 8), boff = lds_byte(wc * 32 + fr, fq * 8);
#define PG8_SA(b, h) (((b) * 2 + (h)) * HTB)
#define PG8_SB(b, h) ((4 + (b) * 2 + (h)) * HTB)
#define PG8_STAGE(bufoff, gbase, voff) do { _Pragma("unroll") for (int _i = 0; _i < 2; ++_i) \
        __builtin_amdgcn_global_load_lds((const unsigned*)((const char*)(gbase) + (voff)[_i]), (PG8_LAS unsigned*)(lds + (bufoff) + ldsw + _i * 8192), 16, 0, 0); } while (0)
#define PG8_LDA(dst, b, h) do { _Pragma("unroll") for (int m = 0; m < 4; ++m) _Pragma("unroll") for (int k = 0; k < 2; ++k) dst[m][k] = *(const PG8_LAS bf16x8*)(lds + PG8_SA(b, h) + aoff + m * 2048 + k * 1024); } while (0)
#define PG8_LDB(dst, b, h) do { _Pragma("unroll") for (int n = 0; n < 2; ++n) _Pragma("unroll") for (int k = 0; k < 2; ++k) dst[n][k] = *(const PG8_LAS bf16x8*)(lds + PG8_SB(b, h) + boff + n * 2048 + k * 1024); } while (0)
#define PG8_MMA(ai, bj, At, Bt) do { __builtin_amdgcn_s_setprio(1); _Pragma("unroll") for (int m = 0; m < 4; ++m) _Pragma("unroll") for (int n = 0; n < 2; ++n) _Pragma("unroll") for (int k = 0; k < 2; ++k) \
        acc[ai][bj][m][n] = __builtin_amdgcn_mfma_f32_16x16x32_bf16(Bt[n][k], At[m][k], acc[ai][bj][m][n], 0, 0, 0); __builtin_amdgcn_s_setprio(0); } while (0)
#define PG8_WAIT_V(n) asm volatile("s_waitcnt vmcnt(" #n ")" ::: "memory")
#define PG8_WAIT_L(n) asm volatile("s_waitcnt lgkmcnt(" #n ")" ::: "memory")
#define PG8_BAR __builtin_amdgcn_s_barrier()
#define PG8_SCHED __builtin_amdgcn_sched_barrier(0)
    Unit cur, nxt; int ui = 0;
    if (!S.next(0, cur)) return;
    f32x4 acc[2][2][4][2];
#pragma unroll
    for (int a = 0; a < 2; ++a)
#pragma unroll
        for (int b = 0; b < 2; ++b)
#pragma unroll
            for (int m = 0; m < 4; ++m)
#pragma unroll
                for (int n = 0; n < 2; ++n) acc[a][b][m][n] = (f32x4){0.f, 0.f, 0.f, 0.f};
    bf16x8 At[4][2], B0[2][2], B1[2][2];
    const char* cA = (const char*)g.A + (size_t)cur.pm * tstep; const char* cB = (const char*)g.Bt + (size_t)cur.pn * tstep;
    S.a_ready(cur);
    if constexpr (SP2) {
        PG8_STAGE(PG8_SB(0, 0), cB, voffB); PG8_STAGE(PG8_SB(0, 1), cB + hstep, voffB); PG8_STAGE(PG8_SA(0, 0), cA, voffA); PG8_STAGE(PG8_SA(0, 1), cA + hstep, voffA);
        if (wr == 1) PG8_BAR;
        PG8_WAIT_V(2); PG8_BAR;
        PG8_STAGE(PG8_SB(1, 0), cB + kstep, voffB); PG8_STAGE(PG8_SA(1, 0), cA + kstep, voffA); PG8_STAGE(PG8_SB(1, 1), cB + hstep + kstep, voffB);
        PG8_WAIT_V(6); PG8_BAR;
    } else {
        PG8_STAGE(PG8_SB(0, 0), cB, voffB); PG8_STAGE(PG8_SA(0, 0), cA, voffA); PG8_STAGE(PG8_SB(0, 1), cB + hstep, voffB); PG8_STAGE(PG8_SA(0, 1), cA + hstep, voffA);
        if (wr == 1) PG8_BAR;
        PG8_WAIT_V(4); PG8_BAR;
        PG8_STAGE(PG8_SB(1, 0), cB + kstep, voffB); PG8_STAGE(PG8_SA(1, 0), cA + kstep, voffA); PG8_STAGE(PG8_SB(1, 1), cB + hstep + kstep, voffB);
        PG8_WAIT_V(6); PG8_BAR;
    }
    for (;;) {
        const bool has_next = S.next(ui + 1, nxt);
        const char* nA = has_next ? (const char*)g.A + (size_t)nxt.pm * tstep : cA; const char* nB = has_next ? (const char*)g.Bt + (size_t)nxt.pn * tstep : cB;
        for (int t = 0; t < nt; t += 2) {
            const bool last = (t == nt - 2);
            const char* a1 = cA + (size_t)(t + 1) * kstep;
            const char* a2 = last ? nA : cA + (size_t)(t + 2) * kstep; const char* b2 = last ? nB : cB + (size_t)(t + 2) * kstep;
            const char* a3 = a2 + kstep; const char* b3 = b2 + kstep;
            if (last && has_next) S.a_ready(nxt);
            if constexpr (SP2) {
            PG8_LDB(B0, 0, 0); PG8_LDB(B1, 0, 1); PG8_SCHED; PG8_LDA(At, 0, 0); PG8_STAGE(PG8_SA(1, 1), a1 + hstep, voffA);
            PG8_WAIT_V(8); PG8_WAIT_L(0); PG8_BAR; PG8_MMA(0, 0, At, B0); PG8_MMA(0, 1, At, B1); PG8_BAR; PG8_SCHED;
            PG8_LDA(At, 0, 1); PG8_STAGE(PG8_SB(0, 0), b2, voffB); PG8_STAGE(PG8_SB(0, 1), b2 + hstep, voffB); PG8_STAGE(PG8_SA(0, 0), a2, voffA);
            PG8_WAIT_V(8); PG8_WAIT_L(0); PG8_BAR; PG8_MMA(1, 0, At, B0); PG8_MMA(1, 1, At, B1); PG8_BAR; PG8_SCHED;
            PG8_LDB(B0, 1, 0); PG8_LDB(B1, 1, 1); PG8_SCHED; PG8_LDA(At, 1, 0); PG8_STAGE(PG8_SA(0, 1), a2 + hstep, voffA);
            PG8_WAIT_V(8); PG8_WAIT_L(0); PG8_BAR; PG8_MMA(0, 0, At, B0); PG8_MMA(0, 1, At, B1); PG8_BAR; PG8_SCHED;
            PG8_LDA(At, 1, 1); PG8_STAGE(PG8_SB(1, 0), b3, voffB); PG8_STAGE(PG8_SB(1, 1), b3 + hstep, voffB); PG8_STAGE(PG8_SA(1, 0), a3, voffA);
            PG8_WAIT_V(8); PG8_WAIT_L(0); PG8_BAR; PG8_MMA(1, 0, At, B0); PG8_MMA(1, 1, At, B1); PG8_BAR; PG8_SCHED;
            } else {
            PG8_LDB(B0, 0, 0); PG8_SCHED; PG8_LDA(At, 0, 0); PG8_STAGE(PG8_SA(1, 1), a1 + hstep, voffA);
            PG8_WAIT_L(8); PG8_BAR; PG8_WAIT_L(0); PG8_MMA(0, 0, At, B0); PG8_BAR; PG8_SCHED;
            PG8_LDB(B1, 0, 1); PG8_STAGE(PG8_SB(0, 0), b2, voffB);
            PG8_BAR; PG8_WAIT_L(0); PG8_MMA(0, 1, At, B1); PG8_BAR;
            PG8_LDA(At, 0, 1); PG8_STAGE(PG8_SA(0, 0), a2, voffA);
            PG8_BAR; PG8_WAIT_L(0); PG8_MMA(1, 0, At, B0); PG8_BAR; PG8_SCHED;
            PG8_STAGE(PG8_SB(0, 1), b2 + hstep, voffB);
            PG8_WAIT_V(6); PG8_BAR; PG8_MMA(1, 1, At, B1); PG8_BAR;
            PG8_LDB(B0, 1, 0); PG8_SCHED; PG8_LDA(At, 1, 0); PG8_STAGE(PG8_SA(0, 1), a2 + hstep, voffA);
            PG8_WAIT_L(8); PG8_BAR; PG8_WAIT_L(0); PG8_MMA(0, 0, At, B0); PG8_BAR; PG8_SCHED;
            PG8_LDB(B1, 1, 1); PG8_STAGE(PG8_SB(1, 0), b3, voffB);
            PG8_BAR; PG8_WAIT_L(0); PG8_MMA(0, 1, At, B1); PG8_BAR;
            PG8_LDA(At, 1, 1); PG8_STAGE(PG8_SA(1, 0), a3, voffA);
            PG8_BAR; PG8_WAIT_L(0); PG8_MMA(1, 0, At, B0); PG8_BAR; PG8_SCHED;
            PG8_STAGE(PG8_SB(1, 1), b3 + hstep, voffB);
            PG8_WAIT_V(6); PG8_BAR; PG8_MMA(1, 1, At, B1); PG8_BAR;
            }
        }
        if constexpr (ALIGN_EPI) { if (wr == 0) PG8_BAR; }
        if constexpr (!Epi::AFTER_DRAIN) { E(acc, cur, wr, wc, fr, fq); S.done(cur); }
        if (!has_next) break;
#pragma unroll
        for (int a = 0; a < 2; ++a)
#pragma unroll
            for (int b = 0; b < 2; ++b)
#pragma unroll
                for (int m = 0; m < 4; ++m)
#pragma unroll
                    for (int n = 0; n < 2; ++n) acc[a][b][m][n] = (f32x4){0.f, 0.f, 0.f, 0.f};
        cur = nxt; cA = nA; cB = nB; ++ui;
        if constexpr (ALIGN_EPI) { if (wr == 1) PG8_BAR; }
    }
    PG8_WAIT_V(0);
    if constexpr (!ALIGN_EPI) { if (wr == 0) PG8_BAR; }
    PG8_BAR;
    if constexpr (Epi::AFTER_DRAIN) { E.fused(acc, cur, wr, wc, fr, fq, lds, wid, lane); S.done(cur); }
#undef PG8_SA
#undef PG8_SB
#undef PG8_STAGE
#undef PG8_LDA
#undef PG8_LDB
#undef PG8_MMA
#undef PG8_WAIT_V
#undef PG8_WAIT_L
#undef PG8_BAR
#undef PG8_SCHED
}
}
namespace att {
using bf16 = __hip_bfloat16;
using bf16x8 = __attribute__((ext_vector_type(8))) short;
using s16x4  = __attribute__((ext_vector_type(4))) short;
using f32x16 = __attribute__((ext_vector_type(16))) float;
using u32x4  = __attribute__((ext_vector_type(4))) unsigned;
constexpr int SEQ = 4096, QROWS = 128, KVBLK = 64, LDP = 6144, LDC = 2048;
constexpr int SHM_V = KVBLK * 128 * 2, SHM_K = KVBLK * 128 * 2;
constexpr int OFF_WS = 3 * SHM_V + 3 * SHM_K;
constexpr int OFF_STG = 4 * 16384;
constexpr int ATT_LDS = OFF_WS + 8 * 64 * 4;
constexpr float THR = 8.f;
#ifndef ATT_SDEPTH
#define ATT_SDEPTH 1
#endif
constexpr int SDEPTH = ATT_SDEPTH;
#define KSWZ(row, colB) ((row) * 256 + ((colB) ^ (((row) & 15) << 4)))
#define SBAR() __builtin_amdgcn_sched_barrier(0)
__device__ __forceinline__ int crow(int r, int hi) { return (r & 3) + 8 * (r >> 2) + 4 * hi; }
typedef float f32x2_t __attribute__((ext_vector_type(2))); typedef __bf16 bf16x2_t __attribute__((ext_vector_type(2)));
__device__ __forceinline__ unsigned cvtpk(float lo, float hi) { f32x2_t v = {lo, hi}; bf16x2_t b = __builtin_convertvector(v, bf16x2_t); return __builtin_bit_cast(unsigned, b); }
__device__ __forceinline__ void partialSM(f32x16& p0, f32x16& p1, float& m_reg, float& mn, float& alpha) {
  float pmax = p0[0];
#pragma unroll
  for (int r = 1; r < 16; ++r) pmax = fmaxf(pmax, p0[r]);
#pragma unroll
  for (int r = 0; r < 16; ++r) pmax = fmaxf(pmax, p1[r]);
  { auto rr = __builtin_amdgcn_permlane32_swap(__float_as_uint(pmax), __float_as_uint(pmax), false, false);
    pmax = fmaxf(__uint_as_float(rr[0]), __uint_as_float(rr[1])); }
  if (__builtin_expect(__all(pmax - m_reg <= THR), 1)) { mn = m_reg; alpha = 1.f; }
  else { mn = fmaxf(m_reg, pmax); alpha = __builtin_amdgcn_exp2f(m_reg - mn); m_reg = mn; }
#pragma unroll
  for (int r = 0; r < 16; ++r) p0[r] = p0[r] - mn;
#pragma unroll
  for (int r = 0; r < 16; ++r) p1[r] = p1[r] - mn;
#pragma unroll
  for (int r = 0; r < 16; ++r) p0[r] = __builtin_amdgcn_exp2f(p0[r]);
}
__device__ __forceinline__ void finishSM(f32x16& p0, f32x16& p1, float alpha, float& l_reg, bf16x8& pa0, bf16x8& pa1, bf16x8& pa2, bf16x8& pa3) {
#pragma unroll
  for (int r = 0; r < 16; ++r) p1[r] = __builtin_amdgcn_exp2f(p1[r]);
  float ps = 0;
#pragma unroll
  for (int r = 0; r < 16; ++r) ps += p0[r];
#pragma unroll
  for (int r = 0; r < 16; ++r) ps += p1[r];
  { auto rr = __builtin_amdgcn_permlane32_swap(__float_as_uint(ps), __float_as_uint(ps), false, false);
    ps = __uint_as_float(rr[0]) + __uint_as_float(rr[1]); }
  l_reg = l_reg * alpha + ps;
#define PK4(P, BASE, OUT) do { unsigned a0 = cvtpk(P[BASE + 0], P[BASE + 1]), a1 = cvtpk(P[BASE + 2], P[BASE + 3]);   \
    unsigned b0 = cvtpk(P[BASE + 4], P[BASE + 5]), b1 = cvtpk(P[BASE + 6], P[BASE + 7]);                              \
    auto r0 = __builtin_amdgcn_permlane32_swap(a0, b0, false, false); auto r1 = __builtin_amdgcn_permlane32_swap(a1, b1, false, false); \
    u32x4 w = {r0[0], r1[0], r0[1], r1[1]}; OUT = *reinterpret_cast<bf16x8*>(&w); } while (0)
  PK4(p0, 0, pa0); PK4(p0, 8, pa1); PK4(p1, 0, pa2); PK4(p1, 8, pa3);
#undef PK4
}
__device__ __forceinline__ void qkt(f32x16& p0, f32x16& p1, const char* Ks, const bf16x8* qr, int r32, int hi, int cbase) {
  p0 = f32x16{}; p1 = f32x16{};
#pragma unroll
  for (int d0 = 0; d0 < 4; ++d0) { const int cb = cbase + (d0 * 16 + hi * 8) * 2;
    bf16x8 b0 = *reinterpret_cast<const bf16x8*>(Ks + KSWZ(r32, cb));
    bf16x8 b1 = *reinterpret_cast<const bf16x8*>(Ks + KSWZ(32 + r32, cb));
    p0 = __builtin_amdgcn_mfma_f32_32x32x16_bf16(b0, qr[d0], p0, 0, 0, 0);
    p1 = __builtin_amdgcn_mfma_f32_32x32x16_bf16(b1, qr[d0], p1, 0, 0, 0); }
}
__device__ __forceinline__ int v_st(int k, int c) { const int kk = (k & ~0xC) | ((k & 4) << 1) | ((k & 8) >> 1); return ((kk >> 3) * 4 + (c >> 5)) * 512 + ((kk & 7) * 32 + (c & 31)) * 2; }
__device__ __forceinline__ int v_rd_base(int lane) { return ((lane & 3) << 3) | (((lane >> 2) & 3) << 6) | (((lane >> 4) & 1) << 5) | (((lane >> 5) & 1) << 8); }
constexpr int v_rd_off(int d0, int ks, int half) { return d0 * 512 + ks * 4096 + half * 2048; }
typedef short v4i16_t __attribute__((ext_vector_type(4)));
template <int OFF> __device__ __forceinline__ s16x4 tr_read(int vb) {
  return __builtin_bit_cast(s16x4, __builtin_amdgcn_ds_read_tr16_b64_v4i16((__attribute__((address_space(3))) v4i16_t*)(uintptr_t)(unsigned)(vb + OFF)));
}
#define SGB(mask, n) __builtin_amdgcn_sched_group_barrier(mask, n, 0)
__device__ __forceinline__ void pv_d0(f32x16* o, int vb, bf16x8 pa0, bf16x8 pa1, bf16x8 pa2, bf16x8 pa3) {
#define PK(L, H) (bf16x8){L[0], L[1], L[2], L[3], H[0], H[1], H[2], H[3]}
#define KSTEP(KS, PA) do { \
    const s16x4 l0 = tr_read<v_rd_off(0, KS, 0)>(vb), h0 = tr_read<v_rd_off(0, KS, 1)>(vb), l1 = tr_read<v_rd_off(1, KS, 0)>(vb), h1 = tr_read<v_rd_off(1, KS, 1)>(vb); \
    const s16x4 l2 = tr_read<v_rd_off(2, KS, 0)>(vb), h2 = tr_read<v_rd_off(2, KS, 1)>(vb), l3 = tr_read<v_rd_off(3, KS, 0)>(vb), h3 = tr_read<v_rd_off(3, KS, 1)>(vb); \
    o[0] = __builtin_amdgcn_mfma_f32_32x32x16_bf16(PA, PK(l0, h0), o[0], 0, 0, 0); o[1] = __builtin_amdgcn_mfma_f32_32x32x16_bf16(PA, PK(l1, h1), o[1], 0, 0, 0); \
    o[2] = __builtin_amdgcn_mfma_f32_32x32x16_bf16(PA, PK(l2, h2), o[2], 0, 0, 0); o[3] = __builtin_amdgcn_mfma_f32_32x32x16_bf16(PA, PK(l3, h3), o[3], 0, 0, 0); } while (0)
  KSTEP(0, pa0); KSTEP(1, pa1); KSTEP(2, pa2); KSTEP(3, pa3);
#undef KSTEP
#undef PK
}
__device__ __forceinline__ void conv_tile(const bf16* __restrict__ proj, bf16* __restrict__ cat, const float* __restrict__ cw, long row0, int ch0, int lane) {
  const int c8 = ch0 + (lane & 15) * 8; const long r0 = row0 + (lane >> 4) * 8;
  float w0[8], w1[8], w2[8];
#pragma unroll
  for (int e = 0; e < 8; ++e) { w0[e] = cw[c8 + e]; w1[e] = cw[1024 + c8 + e]; w2[e] = cw[2048 + c8 + e]; }
#define LDZ(row, z) do { const bf16x8 c_ = *reinterpret_cast<const bf16x8*>(proj + (long)(row) * LDP + 4096 + c8);     \
    _Pragma("unroll") for (int e = 0; e < 8; ++e) z[e] = __uint_as_float(((unsigned)(unsigned short)c_[e]) << 16); } while (0)
  float zp[8], zc[8], zn[8];
  if ((r0 & (SEQ - 1)) == 0) {
#pragma unroll
    for (int e = 0; e < 8; ++e) zp[e] = 0.f;
  } else LDZ(r0 - 1, zp);
  LDZ(r0, zc);
#pragma unroll
  for (int i = 0; i < 8; ++i) { const long row = r0 + i;
    if (((row + 1) & (SEQ - 1)) == 0) {
#pragma unroll
      for (int e = 0; e < 8; ++e) zn[e] = 0.f;
    } else LDZ(row + 1, zn);
    const bf16x8 gb = *reinterpret_cast<const bf16x8*>(proj + row * LDP + 3072 + c8);
    float y[8];
#pragma unroll
    for (int e = 0; e < 8; ++e) y[e] = __uint_as_float(((unsigned)(unsigned short)gb[e]) << 16) * (zp[e] * w0[e] + zc[e] * w1[e] + zn[e] * w2[e]);
    u32x4 w; w.x = cvtpk(y[0], y[1]); w.y = cvtpk(y[2], y[3]); w.z = cvtpk(y[4], y[5]); w.w = cvtpk(y[6], y[7]);
    *(u32x4*)(cat + row * LDC + 1024 + c8) = w;
#pragma unroll
    for (int e = 0; e < 8; ++e) { zp[e] = zc[e]; zc[e] = zn[e]; }
  }
#undef LDZ
}
__device__ __forceinline__ void glds16(const void* base, unsigned voff, unsigned lds_dst) { unsigned keep;
  asm volatile("s_mov_b32 %0, m0\n\ts_mov_b32 m0, %3\n\ts_nop 0\n\tglobal_load_lds_dwordx4 %1, %2\n\ts_mov_b32 m0, %0" : "=&s"(keep) : "v"(voff), "s"(base), "s"(lds_dst) : "memory"); }
#define WAIT_BAR(N) asm volatile("s_waitcnt vmcnt(" #N ") lgkmcnt(0)\n\ts_barrier" ::: "memory")
__device__ __forceinline__ void attn_unit(const bf16* __restrict__ proj, bf16* __restrict__ cat, int b, int h, int qb, float lam, float oscale, const float* __restrict__ subln, const float* __restrict__ cw, char* lds) {
  int tid_ = threadIdx.x; asm volatile("" : "+v"(tid_));
  const int tid = tid_, wid = __builtin_amdgcn_readfirstlane(tid >> 6), lane = tid & 63, r32 = lane & 31, hi = lane >> 5, rg = wid & 3, mp = wid >> 2;
  char* K_lds = lds; char* V_lds = lds + 3 * SHM_K;
  float* ws = (float*)(lds + OFF_WS) + wid * 64; float* li_l = ws; float* al_l = ws + 32;
  const long rowbase = (long)b * SEQ;
  const bf16* Kh = proj + rowbase * LDP + 1024 + h * 128; const bf16* Vh = proj + rowbase * LDP + 2048 + h * 128;
  float m_reg = -1e30f, l_reg = 0; f32x16 o[4] = {}; bf16x8 qr[4];
  const bf16* Qw = proj + (rowbase + qb * QROWS + rg * 32 + r32) * LDP + (2 * h + mp) * 64 + hi * 8;
#pragma unroll
  for (int d0 = 0; d0 < 4; ++d0) qr[d0] = *reinterpret_cast<const bf16x8*>(Qw + d0 * 16);
  const int cbase = mp * 128;
  unsigned kofs[2], vofs[2];
#pragma unroll
  for (int i = 0; i < 2; ++i) { const int q = wid + 8 * i, p = 64 * q + lane;
    const int krow = p >> 4, kc8 = (p & 15) ^ (krow & 15); kofs[i] = (unsigned)(krow * LDP + kc8 * 8) * 2u;
    const int kk = (p >> 7) * 8 + ((p & 31) >> 2), c = ((p >> 5) & 3) * 32 + (p & 3) * 8, k = (kk & ~0xC) | ((kk & 4) << 1) | ((kk & 8) >> 1); vofs[i] = (unsigned)(k * LDP + c) * 2u; }
  const unsigned lds0 = (unsigned)(uintptr_t)lds, kdst = lds0 + wid * 1024, vdst = lds0 + 3 * SHM_K + wid * 1024;
#define DMA_K(t, slot) do { const bf16* kb_ = Kh + (long)(t) * KVBLK * LDP; glds16(kb_, kofs[0], kdst + (slot) * SHM_K); glds16(kb_, kofs[1], kdst + (slot) * SHM_K + 8192); } while (0)
#define DMA_V(t, slot) do { const bf16* vb_ = Vh + (long)(t) * KVBLK * LDP; glds16(vb_, vofs[0], vdst + (slot) * SHM_V); glds16(vb_, vofs[1], vdst + (slot) * SHM_V + 8192); } while (0)
  const int vb0 = (int)(lds0 + 3 * SHM_K) + v_rd_base(lane);
#define RESC(a) do { if (__any((a) < 1.f)) { if (hi == 0) al_l[r32] = (a); asm volatile("s_waitcnt lgkmcnt(0)" ::: "memory"); \
    _Pragma("unroll") for (int d = 0; d < 4; ++d) _Pragma("unroll") for (int r = 0; r < 16; ++r) o[d][r] *= al_l[crow(r, hi)]; } } while (0)
  f32x16 pA0, pA1, pB0, pB1; float mnA, mnB, alA, alB; bf16x8 pa0, pa1, pa2, pa3; constexpr int NT = SEQ / KVBLK;
  asm volatile("s_waitcnt vmcnt(0)" ::: "memory");
  DMA_K(0, 0); DMA_V(0, 0); DMA_K(1, 1);
  WAIT_BAR(2);
  qkt(pA0, pA1, K_lds, qr, r32, hi, cbase); partialSM(pA0, pA1, m_reg, mnA, alA);
#pragma unroll
  for (int r = 0; r < 16; ++r) pA1[r] = __builtin_amdgcn_exp2f(pA1[r]);
  DMA_V(1, 1); DMA_K(2, 2);
  WAIT_BAR(4);
  int sj = 1;
#define PIN(x) asm volatile("" : "+v"(x))
#define MX3(a, b, c) __builtin_fmaxf(__builtin_fmaxf((a), (b)), (c))
#define PK4(P, BASE, OUT) do { const unsigned a0_ = cvtpk(P[BASE + 0], P[BASE + 1]), a1_ = cvtpk(P[BASE + 2], P[BASE + 3]), b0_ = cvtpk(P[BASE + 4], P[BASE + 5]), b1_ = cvtpk(P[BASE + 6], P[BASE + 7]); \
    auto r0_ = __builtin_amdgcn_permlane32_swap(a0_, b0_, false, false); auto r1_ = __builtin_amdgcn_permlane32_swap(a1_, b1_, false, false); \
    u32x4 w_ = {r0_[0], r1_[0], r0_[1], r1_[1]}; OUT = __builtin_bit_cast(bf16x8, w_); } while (0)
#define PKV(L, H) (bf16x8){L[0], L[1], L[2], L[3], H[0], H[1], H[2], H[3]}
#define RDV(KS, L, H) do { _Pragma("unroll") for (int d_ = 0; d_ < 4; ++d_) { \
    L[d_] = __builtin_bit_cast(s16x4, __builtin_amdgcn_ds_read_tr16_b64_v4i16((__attribute__((address_space(3))) v4i16_t*)(uintptr_t)(unsigned)(vb_ + d_ * 512 + (KS) * 4096))); \
    H[d_] = __builtin_bit_cast(s16x4, __builtin_amdgcn_ds_read_tr16_b64_v4i16((__attribute__((address_space(3))) v4i16_t*)(uintptr_t)(unsigned)(vb_ + d_ * 512 + (KS) * 4096 + 2048))); } } while (0)
#define PVM(D, PA, L, H) o[D] = __builtin_amdgcn_mfma_f32_32x32x16_bf16(PA, PKV(L[D], H[D]), o[D], 0, 0, 0)
#define STEP(PC0, PC1, PP0, PP1, alC, alP, j) do { \
    const int s2_ = (sj == 0) ? 2 : sj - 1, s1_ = (sj == 2) ? 0 : sj + 1; \
    if ((j) + 2 < NT) DMA_K((j) + 2, s2_); if ((j) + 1 < NT) DMA_V((j) + 1, s1_); \
    SBAR(); \
    { const char* Ks_ = K_lds + sj * SHM_K; bf16x8 kf[8]; \
      _Pragma("unroll") for (int d0 = 0; d0 < 4; ++d0) { const int cb = cbase + (d0 * 16 + hi * 8) * 2; \
        kf[2 * d0] = *reinterpret_cast<const bf16x8*>(Ks_ + KSWZ(r32, cb)); kf[2 * d0 + 1] = *reinterpret_cast<const bf16x8*>(Ks_ + KSWZ(32 + r32, cb)); } \
      SBAR(); float ps = 0.f; \
      PC0 = __builtin_amdgcn_mfma_f32_32x32x16_bf16(kf[0], qr[0], f32x16{}, 0, 0, 0); _Pragma("unroll") for (int r = 0; r < 8; ++r) ps += PP0[r]; PIN(ps); SBAR(); \
      PC1 = __builtin_amdgcn_mfma_f32_32x32x16_bf16(kf[1], qr[0], f32x16{}, 0, 0, 0); _Pragma("unroll") for (int r = 8; r < 16; ++r) ps += PP0[r]; PIN(ps); SBAR(); \
      PC0 = __builtin_amdgcn_mfma_f32_32x32x16_bf16(kf[2], qr[1], PC0, 0, 0, 0); _Pragma("unroll") for (int r = 0; r < 8; ++r) ps += PP1[r]; PIN(ps); SBAR(); \
      PC1 = __builtin_amdgcn_mfma_f32_32x32x16_bf16(kf[3], qr[1], PC1, 0, 0, 0); _Pragma("unroll") for (int r = 8; r < 16; ++r) ps += PP1[r]; PIN(ps); SBAR(); \
      PC0 = __builtin_amdgcn_mfma_f32_32x32x16_bf16(kf[4], qr[2], PC0, 0, 0, 0); \
      { auto rr = __builtin_amdgcn_permlane32_swap(__float_as_uint(ps), __float_as_uint(ps), false, false); ps = __uint_as_float(rr[0]) + __uint_as_float(rr[1]); } \
      l_reg = l_reg * alP + ps; PK4(PP0, 0, pa0); PIN(l_reg); PIN(pa0); SBAR(); \
      PC1 = __builtin_amdgcn_mfma_f32_32x32x16_bf16(kf[5], qr[2], PC1, 0, 0, 0); PK4(PP0, 8, pa1); PIN(pa1); SBAR(); \
      PC0 = __builtin_amdgcn_mfma_f32_32x32x16_bf16(kf[6], qr[3], PC0, 0, 0, 0); PK4(PP1, 0, pa2); PIN(pa2); SBAR(); \
      PC1 = __builtin_amdgcn_mfma_f32_32x32x16_bf16(kf[7], qr[3], PC1, 0, 0, 0); PK4(PP1, 8, pa3); PIN(pa3); SBAR(); } \
    { const int vb_ = vb0 + s2_ * SHM_V; s16x4 La[4], Ha[4], Lb[4], Hb[4], Lc[4], Hc[4]; float pm, mn_; \
      RDV(0, La, Ha); RDV(1, Lb, Hb); RDV(2, Lc, Hc); SBAR(); \
      PVM(0, pa0, La, Ha); pm = MX3(PC0[0], PC0[1], PC0[2]); pm = MX3(pm, PC0[3], PC0[4]); pm = MX3(pm, PC0[5], PC0[6]); pm = MX3(pm, PC0[7], PC0[8]); PIN(pm); SBAR(); \
      PVM(1, pa0, La, Ha); pm = MX3(pm, PC0[9], PC0[10]); pm = MX3(pm, PC0[11], PC0[12]); pm = MX3(pm, PC0[13], PC0[14]); pm = MX3(pm, PC0[15], PC1[0]); PIN(pm); SBAR(); \
      PVM(2, pa0, La, Ha); pm = MX3(pm, PC1[1], PC1[2]); pm = MX3(pm, PC1[3], PC1[4]); pm = MX3(pm, PC1[5], PC1[6]); pm = MX3(pm, PC1[7], PC1[8]); PIN(pm); SBAR(); \
      PVM(3, pa0, La, Ha); pm = MX3(pm, PC1[9], PC1[10]); pm = MX3(pm, PC1[11], PC1[12]); pm = MX3(pm, PC1[13], PC1[14]); pm = __builtin_fmaxf(pm, PC1[15]); PIN(pm); SBAR(); \
      RDV(3, La, Ha); SBAR(); \
      PVM(0, pa1, Lb, Hb); \
      { auto rr = __builtin_amdgcn_permlane32_swap(__float_as_uint(pm), __float_as_uint(pm), false, false); pm = __builtin_fmaxf(__uint_as_float(rr[0]), __uint_as_float(rr[1])); } \
      { const bool keep_ = __all(pm - m_reg <= THR); mn_ = keep_ ? m_reg : __builtin_fmaxf(m_reg, pm); alC = keep_ ? 1.f : __builtin_amdgcn_exp2f(m_reg - mn_); m_reg = mn_; } PIN(mn_); PIN(alC); SBAR(); \
      PVM(1, pa1, Lb, Hb); _Pragma("unroll") for (int r = 0; r < 8; ++r) PC0[r] -= mn_; PIN(PC0); SBAR(); \
      PVM(2, pa1, Lb, Hb); _Pragma("unroll") for (int r = 8; r < 16; ++r) PC0[r] -= mn_; PIN(PC0); SBAR(); \
      PVM(3, pa1, Lb, Hb); _Pragma("unroll") for (int r = 0; r < 8; ++r) PC1[r] -= mn_; PIN(PC1); SBAR(); \
      PVM(0, pa2, Lc, Hc); _Pragma("unroll") for (int r = 8; r < 16; ++r) PC1[r] -= mn_; PIN(PC1); SBAR(); \
      PVM(1, pa2, Lc, Hc); _Pragma("unroll") for (int r = 0; r < 4; ++r) PC0[r] = __builtin_amdgcn_exp2f(PC0[r]); PIN(PC0); SBAR(); \
      PVM(2, pa2, Lc, Hc); _Pragma("unroll") for (int r = 4; r < 8; ++r) PC0[r] = __builtin_amdgcn_exp2f(PC0[r]); PIN(PC0); SBAR(); \
      PVM(3, pa2, Lc, Hc); _Pragma("unroll") for (int r = 8; r < 12; ++r) PC0[r] = __builtin_amdgcn_exp2f(PC0[r]); PIN(PC0); SBAR(); \
      PVM(0, pa3, La, Ha); _Pragma("unroll") for (int r = 12; r < 16; ++r) PC0[r] = __builtin_amdgcn_exp2f(PC0[r]); PIN(PC0); SBAR(); \
      PVM(1, pa3, La, Ha); _Pragma("unroll") for (int r = 0; r < 5; ++r) PC1[r] = __builtin_amdgcn_exp2f(PC1[r]); PIN(PC1); SBAR(); \
      PVM(2, pa3, La, Ha); _Pragma("unroll") for (int r = 5; r < 10; ++r) PC1[r] = __builtin_amdgcn_exp2f(PC1[r]); PIN(PC1); SBAR(); \
      PVM(3, pa3, La, Ha); _Pragma("unroll") for (int r = 10; r < 16; ++r) PC1[r] = __builtin_amdgcn_exp2f(PC1[r]); PIN(PC1); SBAR(); } \
    RESC(alC); \
    if ((j) + 2 < NT) WAIT_BAR(4); else if ((j) + 1 < NT) WAIT_BAR(2); else WAIT_BAR(0); \
    sj = s1_; } while (0)
  for (int j = 1; j + 1 < NT; j += 2) {
    STEP(pB0, pB1, pA0, pA1, alB, alA, j);
    STEP(pA0, pA1, pB0, pB1, alA, alB, j + 1);
  }
  STEP(pB0, pB1, pA0, pA1, alB, alA, NT - 1);
  { float ps = 0.f;
#pragma unroll
    for (int r = 0; r < 16; ++r) ps += pB0[r];
#pragma unroll
    for (int r = 0; r < 16; ++r) ps += pB1[r];
    { auto rr = __builtin_amdgcn_permlane32_swap(__float_as_uint(ps), __float_as_uint(ps), false, false); ps = __uint_as_float(rr[0]) + __uint_as_float(rr[1]); }
    l_reg = l_reg * alB + ps; PK4(pB0, 0, pa0); PK4(pB0, 8, pa1); PK4(pB1, 0, pa2); PK4(pB1, 8, pa3); }
  SBAR();
  pv_d0(o, vb0 + ((sj == 0) ? 2 : sj - 1) * SHM_V, pa0, pa1, pa2, pa3);
  if (hi == 0) li_l[r32] = l_reg; asm volatile("s_waitcnt lgkmcnt(0)" ::: "memory");
  float rli[16];
#pragma unroll
  for (int r = 0; r < 16; ++r) rli[r] = __builtin_amdgcn_rcpf(li_l[crow(r, hi)]);
  __syncthreads();
  float* X = (float*)(lds + rg * 16384);
  if (mp == 1) {
#pragma unroll
    for (int d0 = 0; d0 < 4; ++d0)
#pragma unroll
      for (int r = 0; r < 16; ++r) X[(d0 * 16 + r) * 64 + lane] = o[d0][r] * rli[r] * lam;
  }
  __syncthreads();
  if (mp == 0) {
    float g[4];
#pragma unroll
    for (int d0 = 0; d0 < 4; ++d0) g[d0] = subln[d0 * 32 + r32] * oscale;
    bf16* stg = (bf16*)(lds + OFF_STG) + rg * (32 * 128);
#pragma unroll
    for (int r = 0; r < 16; ++r) { float s = 0.f;
#pragma unroll
      for (int d0 = 0; d0 < 4; ++d0) { const float v = o[d0][r] * rli[r] - X[(d0 * 16 + r) * 64 + lane]; o[d0][r] = v; s += v * v; }
      s += __shfl_xor(s, 1); s += __shfl_xor(s, 2); s += __shfl_xor(s, 4); s += __shfl_xor(s, 8); s += __shfl_xor(s, 16);
      const float rs = __builtin_amdgcn_rsqf(s * (1.f / 128.f) + 1e-6f); const int orow = crow(r, hi);
#pragma unroll
      for (int d0 = 0; d0 < 4; ++d0) stg[orow * 128 + d0 * 32 + r32] = __float2bfloat16(o[d0][r] * rs * g[d0]); }
    asm volatile("s_waitcnt lgkmcnt(0)" ::: "memory");
    bf16* Ow = cat + (rowbase + qb * QROWS + rg * 32) * LDC + h * 128;
#pragma unroll
    for (int i = 0; i < 8; ++i) { const int row = i * 4 + (lane >> 4), ch = lane & 15; const u32x4 v = *(const u32x4*)(stg + row * 128 + ch * 8); *(u32x4*)(Ow + (long)row * LDC + ch * 8) = v; }
  } else {
    conv_tile(proj, cat, cw, rowbase + qb * QROWS + rg * 32, h * 128, lane);
  }
  asm volatile("s_waitcnt vmcnt(0)" ::: "memory");
  __syncthreads();
#undef DMA_K
#undef DMA_V
#undef RESC
#undef STEP
}
__device__ __forceinline__ void conv_rows(const bf16* __restrict__ proj, bf16* __restrict__ cat, const float* __restrict__ cw, int row0) {
  int tid_ = threadIdx.x; asm volatile("" : "+v"(tid_));
  const int tid = tid_, cg8 = (tid & 127) * 8, rs = tid >> 7, r0 = row0 + rs * 16;
  float w0[8], w1[8], w2[8];
#pragma unroll
  for (int e = 0; e < 8; ++e) { w0[e] = cw[cg8 + e]; w1[e] = cw[1024 + cg8 + e]; w2[e] = cw[2048 + cg8 + e]; }
  auto ldz = [&](int row, float* z) {
    const bf16x8 c = *reinterpret_cast<const bf16x8*>(proj + (long)row * LDP + 4096 + cg8), u = *reinterpret_cast<const bf16x8*>(proj + (long)row * LDP + 5120 + cg8);
#pragma unroll
    for (int e = 0; e < 8; ++e) z[e] = __uint_as_float(((unsigned)(unsigned short)c[e]) << 16) * __uint_as_float(((unsigned)(unsigned short)u[e]) << 16);
  };
  float zp[8], zc[8], zn[8];
  if ((r0 & (SEQ - 1)) == 0) {
#pragma unroll
    for (int e = 0; e < 8; ++e) zp[e] = 0.f;
  } else ldz(r0 - 1, zp);
  ldz(r0, zc);
#pragma unroll 4
  for (int i = 0; i < 16; ++i) { const int row = r0 + i;
    if (((row + 1) & (SEQ - 1)) == 0) {
#pragma unroll
      for (int e = 0; e < 8; ++e) zn[e] = 0.f;
    } else ldz(row + 1, zn);
    const bf16x8 gb = *reinterpret_cast<const bf16x8*>(proj + (long)row * LDP + 3072 + cg8);
    float y[8];
#pragma unroll
    for (int e = 0; e < 8; ++e) y[e] = __uint_as_float(((unsigned)(unsigned short)gb[e]) << 16) * (zp[e] * w0[e] + zc[e] * w1[e] + zn[e] * w2[e]);
    u32x4 w; w.x = cvtpk(y[0], y[1]); w.y = cvtpk(y[2], y[3]); w.z = cvtpk(y[4], y[5]); w.w = cvtpk(y[6], y[7]);
    *(u32x4*)(cat + (long)row * LDC + 1024 + cg8) = w;
#pragma unroll
    for (int e = 0; e < 8; ++e) { zp[e] = zc[e]; zc[e] = zn[e]; }
  }
}
#undef SBAR
}
constexpr int NWAVES = 8;
#ifndef REP_P0
#define REP_P0 1
#endif
#ifndef REP_G1
#define REP_G1 1
#endif
#ifndef REP_AT
#define REP_AT 1
#endif
#ifndef REP_G3
#define REP_G3 1
#endif
#ifndef REP_SYNC
#define REP_SYNC 0
#endif
constexpr int DM = 2048, BATCH = 4, SEQ = 4096, DEPTH = 4, M = BATCH * SEQ, NIN = 6144, DFF = 5632, NGU = 2 * DFF;
constexpr float EPS = 1e-6f;
constexpr size_t MiB = 1u << 20;
constexpr size_t WS_CTL = 0, CTL_ZERO_BYTES = 1 * MiB;
constexpr size_t WS_ROPE = 1 * MiB;
constexpr size_t WS_WIN = 2 * MiB, WS_WOUT = 98 * MiB, WS_WGU = 130 * MiB, WS_WDN = 306 * MiB;
constexpr size_t WS_XN = 394 * MiB, WS_PROJ = 458 * MiB, WS_CAT = 650 * MiB, WS_PART = 714 * MiB, WS_HID = 716 * MiB, WS_END = 892 * MiB;
constexpr int RSTD_OFF = 131072;
constexpr int LDS_BYTES = 147456;
#define LAS __attribute__((address_space(3)))
typedef unsigned short bf16;
typedef unsigned v4u __attribute__((ext_vector_type(4)));
typedef float f32x4 __attribute__((ext_vector_type(4)));
__device__ __forceinline__ unsigned f2bf(float f) { unsigned u = __builtin_bit_cast(unsigned, f); return (u + 0x7fffu + ((u >> 16) & 1u)) >> 16; }
__device__ __forceinline__ unsigned pk2(float lo, float hi) { return f2bf(lo) | (f2bf(hi) << 16); }
__device__ __forceinline__ float wave_sum(float v) {
#pragma unroll
    for (int o = 1; o < 64; o <<= 1) v += __shfl_xor(v, o);
    return v;
}
__device__ __forceinline__ void p0_transpose_item(const float* __restrict__ W, int K, int N, bf16* __restrict__ WT, int dst_row0, int k0, int n0, LAS float* scr, int lane, const float* __restrict__ gk) {
#pragma unroll 8
    for (int i = 0; i < 32; ++i) { const int kk = 2 * i + (lane >> 5); const float gg = gk ? gk[k0 + kk] : 1.f; scr[kk * 33 + (lane & 31)] = W[(size_t)(k0 + kk) * N + n0 + (lane & 31)] * gg; }
    asm volatile("s_waitcnt lgkmcnt(0)" ::: "memory");
    const int c = lane & 7;
#pragma unroll
    for (int j = 0; j < 4; ++j) { const int n = (lane >> 3) + 8 * j; const LAS float* s = scr + (8 * c) * 33 + n;
        v4u o; o.x = pk2(s[0 * 33], s[1 * 33]); o.y = pk2(s[2 * 33], s[3 * 33]); o.z = pk2(s[4 * 33], s[5 * 33]); o.w = pk2(s[6 * 33], s[7 * 33]);
        *(v4u*)(WT + (size_t)(dst_row0 + n) * K + k0 + 8 * c) = o; }
    asm volatile("s_waitcnt lgkmcnt(0)" ::: "memory");
}
#define XB_TMO      128
#define XB_XCNT(j)  (256  + 64 * (j))
#define XB_XSUB(j)  (1280 + 64 * (j))
#define XB_XGEN(j)  (2304 + 64 * (j))
#define XB_TOP      3328
#define XB_TOPGEN   3392
#define XCD_BAR_WORDS 3456
#define XB_SPIN_CAP (1u << 18)

__device__ __forceinline__ unsigned xb_ld(unsigned* p)              { return __hip_atomic_load(p, __ATOMIC_RELAXED, __HIP_MEMORY_SCOPE_AGENT); }
__device__ __forceinline__ unsigned xb_add(unsigned* p, unsigned v) { return __hip_atomic_fetch_add(p, v, __ATOMIC_RELAXED, __HIP_MEMORY_SCOPE_AGENT); }
__device__ __forceinline__ unsigned xb_xcc_id() { return (unsigned)__builtin_amdgcn_s_getreg((3 << 11) | 20) & 0xFu; }
#define XB_SPIN(cond, bar) do { unsigned _sp = 0; while (cond) { __builtin_amdgcn_s_sleep(1); \
    if ((++_sp & 255u) == 0u) { if (xb_ld(&(bar)[XB_TMO])) break; if (_sp > XB_SPIN_CAP) { atomicAdd(&(bar)[XB_TMO], 1u); break; } } } } while (0)

struct XcdBarrier {
    unsigned* bar; unsigned x; unsigned g;
    volatile LAS unsigned* st;
};

__device__ __forceinline__ XcdBarrier xcd_barrier_post(unsigned* bar, volatile LAS unsigned* st) {
    XcdBarrier b; b.bar = bar; b.x = xb_xcc_id(); b.st = st; b.g = gridDim.x * gridDim.y * gridDim.z;
    if (threadIdx.x == 0) (void)xb_add(&bar[XB_XCNT(b.x)], 1u);
    return b;
}
__device__ __forceinline__ void xcd_barrier_complete(unsigned* bar, unsigned x, unsigned& nloc, unsigned& nx, unsigned G) {
    unsigned sum, cnt, mine, sp = 0u;
    for (;;) {
        sum = 0u; cnt = 0u; mine = 0u;
#pragma unroll
        for (unsigned j = 0; j < 16; ++j) { const unsigned c = xb_ld(&bar[XB_XCNT(j)]); sum += c; cnt += (c > 0u) ? 1u : 0u; mine = (j == x) ? c : mine; }
        if (sum == G) break;
        __builtin_amdgcn_s_sleep(1);
        if ((++sp & 255u) == 0u) { if (xb_ld(&bar[XB_TMO])) break; if (sp > XB_SPIN_CAP) { atomicAdd(&bar[XB_TMO], 1u); break; } }
    }
    nloc = mine > 0u ? mine : 1u; nx = cnt > 0u ? cnt : 1u;
}

__device__ __forceinline__ void xcd_barrier(const XcdBarrier& b) {
    asm volatile("s_waitcnt vmcnt(0)" ::: "memory");
    __syncthreads();
    if (threadIdx.x == 0) {
        unsigned* bar = b.bar;
        __builtin_amdgcn_s_waitcnt(0);
        unsigned nloc = b.st[0], nx = b.st[1];
        if (nloc == 0u) { xcd_barrier_complete(bar, b.x, nloc, nx, b.g); b.st[0] = nloc; b.st[1] = nx; }
        const unsigned old = xb_add(&bar[XB_XSUB(b.x)], 1u);
        const unsigned gen = old / nloc;
        if (old + 1u == (gen + 1u) * nloc) {
            __builtin_amdgcn_fence(__ATOMIC_RELEASE, "agent");
            asm volatile("s_waitcnt vmcnt(0)" ::: "memory");
            const unsigned og = xb_add(&bar[XB_TOP], 1u);
            const unsigned tg = og / nx;
            if (og + 1u == (tg + 1u) * nx) xb_add(&bar[XB_TOPGEN], 1u);
            else XB_SPIN(xb_ld(&bar[XB_TOPGEN]) == tg, bar);
            __builtin_amdgcn_fence(__ATOMIC_ACQUIRE, "agent");
            xb_add(&bar[XB_XGEN(b.x)], 1u);
            asm volatile("s_waitcnt vmcnt(0)" ::: "memory");
        } else {
            XB_SPIN(xb_ld(&bar[XB_XGEN(b.x)]) == gen, bar);
            __builtin_amdgcn_fence(__ATOMIC_ACQUIRE, "agent");
            asm volatile("s_waitcnt vmcnt(0)" ::: "memory");
        }
    }
    __syncthreads();
}

struct Args { const float* in[15]; float* out; unsigned char* ws; float lam_init[4]; int pad[2]; };

__device__ __forceinline__ void norm_rows_bf16(const float* __restrict__ x, const float* __restrict__ g, bf16* __restrict__ xn, int gw, int NGW, int lane) {
    asm volatile("" : "+v"(lane));
    f32x4 gv[8];
#pragma unroll
    for (int j = 0; j < 8; ++j) gv[j] = ((const f32x4*)g)[lane + 64 * j];
    for (int m = gw; m < M; m += NGW) {
        const f32x4* xr = (const f32x4*)(x + (size_t)m * DM) + lane; f32x4 v[8]; float s = 0.f;
#pragma unroll
        for (int j = 0; j < 8; ++j) { v[j] = xr[64 * j]; s += (v[j].x * v[j].x + v[j].y * v[j].y) + (v[j].z * v[j].z + v[j].w * v[j].w); }
        const float rstd = 1.0f / sqrtf(wave_sum(s) * (1.f / DM) + EPS);
        unsigned long long* o8 = (unsigned long long*)(xn + (size_t)m * DM) + lane;
#pragma unroll
        for (int j = 0; j < 8; ++j) o8[64 * j] = (unsigned long long)pk2(v[j].x * rstd * gv[j].x, v[j].y * rstd * gv[j].y) | ((unsigned long long)pk2(v[j].z * rstd * gv[j].z, v[j].w * rstd * gv[j].w) << 32);
    }
}
__device__ __forceinline__ void norm_rows_f32(float* x, const float* __restrict__ g, int gw, int NGW, int lane) {
    asm volatile("" : "+v"(lane));
    f32x4 gv[8];
#pragma unroll
    for (int j = 0; j < 8; ++j) gv[j] = ((const f32x4*)g)[lane + 64 * j];
    for (int m = gw; m < M; m += NGW) {
        f32x4* xr = (f32x4*)(x + (size_t)m * DM) + lane; f32x4 v[8]; float s = 0.f;
#pragma unroll
        for (int j = 0; j < 8; ++j) { v[j] = xr[64 * j]; s += (v[j].x * v[j].x + v[j].y * v[j].y) + (v[j].z * v[j].z + v[j].w * v[j].w); }
        const float rstd = 1.0f / sqrtf(wave_sum(s) * (1.f / DM) + EPS);
#pragma unroll
        for (int j = 0; j < 8; ++j) xr[64 * j] = v[j] * rstd * gv[j];
    }
}

__device__ __forceinline__ void rstd_finalize(const float* __restrict__ part, int pm, int np, LAS float* rstd_l) {
    int t = threadIdx.x; asm volatile("" : "+v"(t));
    const int row = t >> 1, half = t & 1, pa = half ? (np + 1) / 2 : 0, pb = half ? np : (np + 1) / 2;
    const float* p = part + (size_t)pm * 32 * 256 + row; float s = 0.f;
    for (int i = pa; i < pb; ++i) s += p[i * 256];
    s += __shfl_xor(s, 1);
    if (half == 0) rstd_l[row] = 1.0f / sqrtf(s * (1.f / DM) + EPS);
    __syncthreads();
}
__device__ __forceinline__ void panel_barrier(unsigned* cnt, unsigned target, bool full) {
    asm volatile("s_waitcnt vmcnt(0)" ::: "memory");
    __syncthreads();
    if (threadIdx.x == 0) {
        if (full) { __builtin_amdgcn_fence(__ATOMIC_RELEASE, "agent"); asm volatile("s_waitcnt vmcnt(0)" ::: "memory"); }
        (void)__hip_atomic_fetch_add(cnt, 1u, __ATOMIC_RELAXED, __HIP_MEMORY_SCOPE_AGENT);
        unsigned sp = 0;
        while (__hip_atomic_load(cnt, __ATOMIC_RELAXED, __HIP_MEMORY_SCOPE_AGENT) < target) { __builtin_amdgcn_s_sleep(1); if (++sp > (1u << 22)) break; }
        __builtin_amdgcn_fence(__ATOMIC_ACQUIRE, "agent");
        asm volatile("s_waitcnt vmcnt(0)" ::: "memory");
    }
    __syncthreads();
}
__global__ void __launch_bounds__(NWAVES * 64, 2) fwd_megakernel(Args args) {
    extern __shared__ __attribute__((aligned(16))) unsigned char lds[];
    cg::grid_group grid = cg::this_grid();
#define GRID_SYNC() do { asm volatile("s_waitcnt vmcnt(0)" ::: "memory"); grid.sync(); } while (0)
    const int tid = threadIdx.x, lane = tid & 63, wave = __builtin_amdgcn_readfirstlane(tid >> 6);
    const int G = gridDim.x, bx = blockIdx.x, vcu = (G % 8 == 0) ? (bx % 8) * (G / 8) + bx / 8 : bx;
    const int gw = vcu * NWAVES + wave, NGW = G * NWAVES;
    unsigned char* ws = args.ws;
    LAS unsigned char* ldsl_ = (LAS unsigned char*)lds;
    const float* x_in = args.in[0]; const float* norm_mix = args.in[1]; const float* w_in = args.in[2];
    const float* lq1 = args.in[3]; const float* lk1 = args.in[4]; const float* lq2 = args.in[5]; const float* lk2 = args.in[6];
    const float* subln = args.in[7]; const float* conv_w = args.in[8]; const float* w_out = args.in[9]; const float* norm_ffn = args.in[10];
    const float* w_gate = args.in[11]; const float* w_up = args.in[12]; const float* w_down = args.in[13]; const float* norm_final = args.in[14];
    float* out = args.out;
    float* PART = (float*)(ws + WS_PART);
    LAS float* rstd_l = (LAS float*)(ldsl_ + RSTD_OFF);
    const int pm0 = 8 * (bx & 7) + ((bx >> 3) & 7);
    float* cosT = (float*)(ws + WS_ROPE); float* sinT = cosT + 4096 * 32;
    bf16* Win_t = (bf16*)(ws + WS_WIN); bf16* Wout_t = (bf16*)(ws + WS_WOUT); bf16* Wgu_t = (bf16*)(ws + WS_WGU); bf16* Wdn_t = (bf16*)(ws + WS_WDN);
    bf16* XN = (bf16*)(ws + WS_XN); bf16* PROJ = (bf16*)(ws + WS_PROJ); bf16* CAT = (bf16*)(ws + WS_CAT); bf16* HID = (bf16*)(ws + WS_HID);
    LAS unsigned char* ldsl = ldsl_;

    volatile LAS unsigned* MISC = (volatile LAS unsigned*)(ldsl_ + RSTD_OFF + 1024);
    if (tid < 32) MISC[tid] = 0u;
    __syncthreads();
    XcdBarrier xbar = xcd_barrier_post((unsigned*)(ws + WS_CTL) + 4096, MISC + 8);
#define XCD_SYNC() xcd_barrier(xbar)
    unsigned* pcnt = (unsigned*)(ws + WS_CTL) + 16384 + 64 * pm0; unsigned pb_target = 0u; bool pb_full = true;
    if (tid == 0) (void)__hip_atomic_fetch_or(pcnt + 1, 1u << xbar.x, __ATOMIC_RELAXED, __HIP_MEMORY_SCOPE_AGENT);
#define PANEL_SYNC() do { pb_target += 4u; panel_barrier(pcnt, pb_target, pb_full); } while (0)
    unsigned* qcnt = (unsigned*)(ws + WS_CTL) + 28672 + 64 * ((bx & 7) >> 1); unsigned qb_target = 0u;
    XcdBarrier pbar = xcd_barrier_post((unsigned*)(ws + WS_CTL) + 32768 + 4096 * ((bx & 7) >> 1), MISC + 10); pbar.g = 64u;
#define PAIR_SYNC() xcd_barrier(pbar)
    for (int rep_ = 0; rep_ < REP_P0; ++rep_) {
        LAS float* scr = (LAS float*)(ldsl + wave * 16384);
        constexpr int I_IN = (DM / 64) * (NIN / 32), I_OUT = (DM / 64) * (DM / 32), I_G = (DM / 64) * (DFF / 32), I_D = (DFF / 64) * (DM / 32);
        constexpr int I_LAYER = I_IN + I_OUT + 2 * I_G + I_D, NITEMS = DEPTH * I_LAYER;
        struct P0Item { const float* src; const float* gk; bf16* dst; int N, K; };
        auto decode = [&](int it, P0Item& I) {
            const int l = it / I_LAYER; int r = it % I_LAYER; const float* W; const float* g = nullptr; bf16* WT; int N, K, d0, kb, c0;
            if (r < I_IN) { N = NIN; K = DM; const int nblk = NIN / 32; kb = r / nblk; c0 = (r % nblk) * 32; d0 = c0;
                if (c0 < 2048) d0 = (c0 & ~255) + 128 * ((c0 >> 5) & 1) + 32 * ((c0 >> 6) & 3);
                else if (c0 >= 4096) { const int isu = c0 >= 5120, c = c0 - 4096 - 1024 * isu; d0 = 4096 + (c >> 7) * 256 + 128 * isu + (c & 127); }
                W = w_in + (size_t)l * DM * NIN; WT = Win_t + (size_t)l * NIN * DM; g = norm_mix + l * DM; }
            else if ((r -= I_IN) < I_OUT) { N = DM; K = DM; const int nblk = DM / 32; kb = r / nblk; c0 = (r % nblk) * 32; d0 = c0;
                W = w_out + (size_t)l * DM * DM; WT = Wout_t + (size_t)l * DM * DM; }
            else if ((r -= I_OUT) < 2 * I_G) { const int up = r >= I_G; if (up) r -= I_G; N = DFF; K = DM; const int nblk = DFF / 32; kb = r / nblk; c0 = (r % nblk) * 32;
                d0 = (c0 >> 7) * 256 + up * 128 + (c0 & 127);
                W = (up ? w_up : w_gate) + (size_t)l * DM * DFF; WT = Wgu_t + (size_t)l * NGU * DM; g = norm_ffn + l * DM; }
            else { r -= 2 * I_G; N = DM; K = DFF; const int nblk = DM / 32; kb = r / nblk; c0 = (r % nblk) * 32; d0 = c0;
                W = w_down + (size_t)l * DFF * DM; WT = Wdn_t + (size_t)l * DM * DFF; }
            const int k0 = kb * 64;
            I.src = W + (size_t)(k0 + (lane >> 3)) * N + c0 + (lane & 7) * 4;
            I.gk = g ? g + k0 + 8 * (lane & 7) : nullptr;
            I.dst = WT + (size_t)(d0 + (lane >> 3)) * K + k0 + 8 * (lane & 7);
            I.N = N; I.K = K;
        };
        P0Item A, B; f32x4 cur[8], nxt[8];
        if (gw < NITEMS) { decode(gw, A);
#pragma unroll
            for (int i = 0; i < 8; ++i) cur[i] = __builtin_nontemporal_load((const f32x4*)(A.src + (size_t)i * 8 * A.N)); }
        for (int it = gw; it < NITEMS; it += NGW) {
            const bool hasB = it + NGW < NITEMS;
            if (hasB) { decode(it + NGW, B);
#pragma unroll
                for (int i = 0; i < 8; ++i) nxt[i] = __builtin_nontemporal_load((const f32x4*)(B.src + (size_t)i * 8 * B.N)); }
#pragma unroll
            for (int i = 0; i < 8; ++i) { LAS float* w = scr + (8 * i + (lane >> 3)) * 33 + (lane & 7) * 4; w[0] = cur[i].x; w[1] = cur[i].y; w[2] = cur[i].z; w[3] = cur[i].w; }
            asm volatile("s_waitcnt lgkmcnt(0)" ::: "memory");
            f32x4 g0 = {1.f, 1.f, 1.f, 1.f}, g1 = g0;
            if (A.gk) { g0 = *(const f32x4*)A.gk; g1 = *(const f32x4*)(A.gk + 4); }
#pragma unroll
            for (int j = 0; j < 4; ++j) { const LAS float* sp = scr + (8 * (lane & 7)) * 33 + (lane >> 3) + 8 * j;
                v4u o; o.x = pk2(sp[0 * 33] * g0.x, sp[1 * 33] * g0.y); o.y = pk2(sp[2 * 33] * g0.z, sp[3 * 33] * g0.w); o.z = pk2(sp[4 * 33] * g1.x, sp[5 * 33] * g1.y); o.w = pk2(sp[6 * 33] * g1.z, sp[7 * 33] * g1.w);
                *(v4u*)(A.dst + (size_t)j * 8 * A.K) = o; }
            asm volatile("s_waitcnt lgkmcnt(0)" ::: "memory");
            if (hasB) { A = B;
#pragma unroll
                for (int i = 0; i < 8; ++i) cur[i] = nxt[i]; }
        }
        for (int i = bx * (NWAVES * 64) + tid; i < 4096 * 32; i += G * NWAVES * 64) {
            const int pos = i >> 5, j = i & 31;
            const float inv_freq = (float)exp2(-(double)j * (13.287712379549449 / 32.0));
            const float ang = (float)pos * inv_freq;
            const double t = (double)ang, kq = rint(t * 0.63661977236758134), y = t - kq * 1.5707963267948966, y2 = y * y;
            const double sn = y * (1.0 + y2 * (-1.0 / 6 + y2 * (1.0 / 120 + y2 * (-1.0 / 5040 + y2 * (1.0 / 362880 + y2 * (-1.0 / 39916800 + y2 * (1.0 / 6227020800.0 + y2 * (-1.0 / 1307674368000.0))))))));
            const double cs = 1.0 + y2 * (-0.5 + y2 * (1.0 / 24 + y2 * (-1.0 / 720 + y2 * (1.0 / 40320 + y2 * (-1.0 / 3628800 + y2 * (1.0 / 479001600.0 + y2 * (-1.0 / 87178291200.0 + y2 * (1.0 / 20922789888000.0))))))));
            const int q = (int)((long long)kq & 3);
            const double sv = (q == 0) ? sn : (q == 1) ? cs : (q == 2) ? -sn : -cs, cv = (q == 0) ? cs : (q == 1) ? -sn : (q == 2) ? -cs : sn;
            cosT[i] = (float)cv; sinT[i] = (float)sv;
        }
    }
    {
        for (int m = gw; m < M; m += NGW) {
            const f32x4* xr = (const f32x4*)(x_in + (size_t)m * DM) + lane; f32x4 v[8]; float sq = 0.f;
#pragma unroll
            for (int j = 0; j < 8; ++j) { v[j] = __builtin_nontemporal_load(xr + 64 * j); sq += (v[j].x * v[j].x + v[j].y * v[j].y) + (v[j].z * v[j].z + v[j].w * v[j].w); }
            sq = wave_sum(sq); if (lane == 0) PART[((size_t)(m >> 8) * 32) * 256 + (m & 255)] = sq;
            unsigned long long* o8 = (unsigned long long*)(XN + (size_t)m * DM) + lane;
#pragma unroll
            for (int j = 0; j < 8; ++j) o8[64 * j] = (unsigned long long)pk2(v[j].x, v[j].y) | ((unsigned long long)pk2(v[j].z, v[j].w) << 32);
        }
    }
    GRID_SYNC();
    pb_full = __builtin_popcount(__builtin_amdgcn_readfirstlane((int)__hip_atomic_load(pcnt + 1, __ATOMIC_RELAXED, __HIP_MEMORY_SCOPE_AGENT))) != 1;

#pragma unroll 1
    for (int l = 0; l < DEPTH; ++l) {
#ifndef NO_G1
        rstd_finalize(PART, pm0, l == 0 ? 1 : 32, rstd_l);
        for (int rep_ = 0; rep_ < REP_G1; ++rep_) { pg8::Gemm g{XN, Win_t + (size_t)l * NIN * DM, M, NIN, DM}; pg8::StaticOrder S; S.init(M, NIN, G, bx);
          pg8::EpiInProj E{PROJ, NIN, cosT, sinT, rstd_l};
          pg8::gemm_phase<pg8::EpiInProj, pg8::StaticOrder, true, true>(ldsl, g, S, E); }
#endif
        PAIR_SYNC();
        {
            float lam;
            { const float a = wave_sum(lq1[l * 64 + lane] * lk1[l * 64 + lane]), b2 = wave_sum(lq2[l * 64 + lane] * lk2[l * 64 + lane]);
              lam = expf(a) - expf(b2) + args.lam_init[l]; }
            const float oscale = 1.0f - args.lam_init[l];
            const int xcd = vcu >> 5, jq = vcu & 31;
#ifndef NO_AT
            for (int rep_ = 0; rep_ < REP_AT; ++rep_)
            for (int i = 0; ; ++i) { int bh, qb;
                if (G == 256) { if (i >= 4) break; bh = xcd * 4 + i; qb = jq; } else { const int u = bx + i * G; if (u >= 1024) break; bh = u >> 5; qb = u & 31; }
                att::attn_unit((const att::bf16*)PROJ, (att::bf16*)CAT, bh >> 3, bh & 7, qb, lam, oscale, subln + l * 128, conv_w + l * 3 * 1024, (char*)lds); }
#endif
        }
        PAIR_SYNC();
#ifndef NO_G2
        { pg8::Gemm g{CAT, Wout_t + (size_t)l * DM * DM, M, DM, DM}; pg8::StaticOrder S; S.init(M, DM, G, bx);
          pg8::EpiResid E{XN, DM, PART};
          pg8::gemm_phase<pg8::EpiResid, pg8::StaticOrder, true, true>(ldsl, g, S, E); }
#endif
        PANEL_SYNC();
#ifndef NO_G3
        rstd_finalize(PART, pm0, 32, rstd_l);
        for (int rep_ = 0; rep_ < REP_G3; ++rep_) { pg8::Gemm g{XN, Wgu_t + (size_t)l * NGU * DM, M, NGU, DM}; pg8::StaticOrder S; S.init(M, NGU, G, bx);
          pg8::EpiSwiGLU E{HID, DFF, rstd_l};
          pg8::gemm_phase<pg8::EpiSwiGLU, pg8::StaticOrder, true, true>(ldsl, g, S, E); }
#endif
        PANEL_SYNC();
#ifndef NO_G4
        { pg8::Gemm g{HID, Wdn_t + (size_t)l * DM * DFF, M, DM, DFF}; pg8::StaticOrder S; S.init(M, DM, G, bx);
          pg8::EpiResid E{XN, DM, PART};
          pg8::gemm_phase<pg8::EpiResid, pg8::StaticOrder, true, true>(ldsl, g, S, E); }
#endif
        PANEL_SYNC();
        for (int rep_ = 0; rep_ < REP_SYNC; ++rep_) XCD_SYNC();
    }
    {
        int lane_ = threadIdx.x & 63; asm volatile("" : "+v"(lane_)); const int lane = lane_;
        f32x4 gv[8];
#pragma unroll
        for (int j = 0; j < 8; ++j) gv[j] = ((const f32x4*)norm_final)[lane + 64 * j];
        for (int k_ = 0; k_ < 8; ++k_) { const int m = pm0 * 256 + (bx >> 6) * 64 + wave * 8 + k_;
            float sq = (lane < 32) ? PART[((size_t)(m >> 8) * 32 + lane) * 256 + (m & 255)] : 0.f;
            sq = wave_sum(sq);
            const float rstd = 1.0f / sqrtf(sq * (1.f / DM) + EPS);
            const unsigned long long* xr = (const unsigned long long*)(XN + (size_t)m * DM) + lane;
            f32x4* orow = (f32x4*)(out + (size_t)m * DM) + lane;
#pragma unroll
            for (int j = 0; j < 8; ++j) { const unsigned long long w = xr[64 * j]; const unsigned lo = (unsigned)w, hi = (unsigned)(w >> 32);
                f32x4 v = {__uint_as_float(lo << 16), __uint_as_float(lo & 0xffff0000u), __uint_as_float(hi << 16), __uint_as_float(hi & 0xffff0000u)};
                __builtin_nontemporal_store(v * rstd * gv[j], orow + 64 * j); }
        }
    }
}

extern "C" void kernel_launch(void* const* d_in, const int* in_sizes, int n_in, void* d_out, int out_size, void* d_ws, size_t ws_size, hipStream_t stream) {
    static int grid = 0;
    if (grid == 0) {
        if (n_in != 15 || in_sizes[0] != M * DM || out_size != M * DM || ws_size < WS_END) {
            fprintf(stderr, "kernel_launch: unexpected shapes: n_in %d in0 %d out %d ws %zu (need >= %zu)\n", n_in, n_in > 0 ? in_sizes[0] : -1, out_size, ws_size, (size_t)WS_END); grid = -1; return; }
        int dev = 0, cus = 0, per_cu = 0;
        if (hipGetDevice(&dev) != hipSuccess || hipDeviceGetAttribute(&cus, hipDeviceAttributeMultiprocessorCount, dev) != hipSuccess) { grid = -1; return; }
        if (hipFuncSetAttribute((const void*)fwd_megakernel, hipFuncAttributeMaxDynamicSharedMemorySize, LDS_BYTES) != hipSuccess) { fprintf(stderr, "kernel_launch: hipFuncSetAttribute failed\n"); grid = -1; return; }
        if (hipOccupancyMaxActiveBlocksPerMultiprocessor(&per_cu, (const void*)fwd_megakernel, NWAVES * 64, LDS_BYTES) != hipSuccess || per_cu < 1) { fprintf(stderr, "kernel_launch: occupancy query says %d\n", per_cu); per_cu = 1; }
        (void)hipGetLastError();
        grid = cus * 1;
    }
    if (grid < 0) return;
    Args a{};
    for (int i = 0; i < 15; ++i) a.in[i] = (const float*)d_in[i];
    a.out = (float*)d_out; a.ws = (unsigned char*)d_ws;
    for (int l = 0; l < 4; ++l) a.lam_init[l] = (float)(0.8 - 0.6 * std::exp(-0.3 * (double)l));
    if (hipMemsetAsync((char*)d_ws + WS_CTL, 0, CTL_ZERO_BYTES, stream) != hipSuccess) { fprintf(stderr, "kernel_launch: memset failed\n"); return; }
    void* kargs[] = {&a};
    hipError_t e = hipLaunchCooperativeKernel((const void*)fwd_megakernel, dim3(grid), dim3(NWAVES * 64), kargs, LDS_BYTES, stream);
    if (e != hipSuccess) fprintf(stderr, "kernel_launch: cooperative launch failed: %s (grid %d)\n", hipGetErrorString(e), grid);
}
```
